# Optimizing an MI355X kernel written in HIP

```python
import jax, jax.numpy as jnp
from jax import lax
import numpy as np

D_MODEL = 1024
BATCH = 2
SEQ = 8192
DEPTH = 1

HG_HEADS = 8
HG_EXPAND = 128
HG_KEY_DIM = HG_HEADS * HG_EXPAND
HG_VAL_DIM = D_MODEL
HG_HEAD_V = HG_VAL_DIM // HG_HEADS
HG_CHUNK = 64
ATT_Q_HEADS = 16
ATT_KV_HEADS = 4
ATT_HEAD_DIM = 64
ATT_GROUP = ATT_Q_HEADS // ATT_KV_HEADS
ATT_WIDTH = ATT_Q_HEADS * ATT_HEAD_DIM
KV_WIDTH = ATT_KV_HEADS * ATT_HEAD_DIM
WINDOW = 128
ATT_BLOCK = WINDOW
EPS = 1e-6

IN_SIZES = [
    HG_KEY_DIM,
    HG_KEY_DIM,
    HG_VAL_DIM,
    HG_VAL_DIM,
    ATT_WIDTH,
    KV_WIDTH,
    KV_WIDTH,
    ATT_WIDTH,
    D_MODEL,
    D_MODEL,
]
D_IN = sum(IN_SIZES)
SPLIT_POINTS = [int(s) for s in np.cumsum(IN_SIZES)[:-1]]

kernel_name = "hybrid_hgrn2_swa_sink_gated_block"


def rms_norm(x, w):
    xf = x.astype(jnp.float32)
    xf = xf * lax.rsqrt(jnp.mean(xf * xf, axis=-1, keepdims=True) + EPS)
    return xf.astype(x.dtype) * w


def hgrn2_chunkwise(q, k, v, log_f):
    B, T, H, dk = q.shape
    dv = v.shape[-1]
    n = T // HG_CHUNK

    def to_chunks(a):
        return a.reshape(B, n, HG_CHUNK, H, a.shape[-1]).transpose(1, 0, 3, 2, 4)

    qc, kc, vc, gc = to_chunks(q), to_chunks(k), to_chunks(v), to_chunks(log_f)
    causal = jnp.tril(jnp.ones((HG_CHUNK, HG_CHUNK), dtype=bool))

    def step(S, inp):
        q_, k_, v_, g_ = inp
        b = jnp.cumsum(g_, axis=2)
        o_inter = jnp.einsum('bhtd,bhdv->bhtv', q_ * jnp.exp(b), S)
        diff = b[:, :, :, None, :] - b[:, :, None, :, :]
        decay = jnp.exp(jnp.where(causal[:, :, None], diff, -jnp.inf))
        scores = jnp.einsum('bhtd,bhsd,bhtsd->bhts', q_, k_, decay)
        o_intra = jnp.einsum('bhts,bhsv->bhtv', scores, v_)
        b_last = b[:, :, -1:, :]
        S_new = jnp.exp(b_last[:, :, 0, :])[..., None] * S + jnp.einsum(
            'bhsd,bhsv->bhdv', k_ * jnp.exp(b_last - b), v_)
        return S_new, o_inter + o_intra

    S0 = jnp.zeros((B, H, dk, dv), jnp.float32)
    _, o = lax.scan(step, S0, (qc, kc, vc, gc))
    return o.transpose(1, 0, 3, 2, 4).reshape(B, T, H, dv)


def sliding_window_attention_with_sinks(q, k, v, sinks):
    B, T = q.shape[0], q.shape[1]
    n = T // ATT_BLOCK
    qb = q.reshape(B, n, ATT_BLOCK, ATT_KV_HEADS, ATT_GROUP, ATT_HEAD_DIM)

    def banded(a):
        ab = a.reshape(B, n, ATT_BLOCK, ATT_KV_HEADS, ATT_HEAD_DIM)
        prev = jnp.pad(ab[:, :-1], ((0, 0), (1, 0), (0, 0), (0, 0), (0, 0)))
        return jnp.concatenate([prev, ab], axis=2)

    keys, vals = banded(k), banded(v)
    scores = jnp.einsum('bnqhgd,bnkhd->bnhgqk', qb, keys).astype(jnp.float32) * (ATT_HEAD_DIM ** -0.5)
    qi = jnp.arange(ATT_BLOCK)[:, None]
    kj = jnp.arange(2 * ATT_BLOCK)[None, :]
    rel = qi + ATT_BLOCK - kj
    band = (rel >= 0) & (rel < WINDOW)
    pad_keys = (jnp.arange(n) == 0)[:, None, None] & (kj < ATT_BLOCK)[None]
    valid = band[None] & ~pad_keys
    scores = jnp.where(valid[None, :, None, None], scores, -jnp.inf)
    sink = sinks.astype(jnp.float32).reshape(ATT_KV_HEADS, ATT_GROUP)[None, None, :, :, None, None]
    m = jnp.maximum(jnp.max(scores, axis=-1, keepdims=True), sink)
    p = jnp.exp(scores - m)
    probs = p / (jnp.sum(p, axis=-1, keepdims=True) + jnp.exp(sink - m))
    out = jnp.einsum('bnhgqk,bnkhd->bnqhgd', probs.astype(v.dtype), vals)
    return out.reshape(B, T, ATT_WIDTH)


def setup_inputs(seed: int = 0) -> dict:
    key = jax.random.key(seed)
    ks = jax.random.split(key, 12)
    f32 = jnp.float32
    return {
        "x": jax.random.normal(ks[0], (BATCH, SEQ, D_MODEL), f32),
        "norm_w": 1.0 + 0.02 * jax.random.normal(ks[1], (DEPTH, D_MODEL), f32),
        "w_in": jax.random.normal(ks[2], (DEPTH, D_MODEL, D_IN), f32) * D_MODEL ** -0.5,
        "hgrn_lower_bound": 0.1 * jax.random.normal(ks[3], (DEPTH + 1, HG_KEY_DIM), f32),
        "hgrn_norm_w": 1.0 + 0.02 * jax.random.normal(ks[4], (DEPTH, HG_VAL_DIM), f32),
        "w_branch_hgrn": jax.random.normal(ks[5], (DEPTH, HG_VAL_DIM, D_MODEL), f32) * HG_VAL_DIM ** -0.5,
        "attn_sinks": 0.5 * jax.random.normal(ks[6], (DEPTH, ATT_Q_HEADS), f32),
        "w_branch_attn": jax.random.normal(ks[7], (DEPTH, ATT_WIDTH, D_MODEL), f32) * ATT_WIDTH ** -0.5,
        "w_out": jax.random.normal(ks[8], (DEPTH, D_MODEL, D_MODEL), f32) * D_MODEL ** -0.5,
        "final_norm_w": 1.0 + 0.02 * jax.random.normal(ks[9], (D_MODEL,), f32),
    }


def reference(x, norm_w, w_in, hgrn_lower_bound, hgrn_norm_w, w_branch_hgrn, attn_sinks,
              w_branch_attn, w_out, final_norm_w):
    B, T, _ = x.shape
    lb_all = jnp.cumsum(jax.nn.softmax(hgrn_lower_bound.astype(jnp.float32), axis=0), axis=0)
    for l in range(DEPTH):
        xn = rms_norm(x, norm_w[l])
        proj = xn @ w_in[l]
        hq, hf, hi, hg, aq, ak, av, ag, mh, ma = jnp.split(proj, SPLIT_POINTS, axis=-1)

        lb = lb_all[l]
        f = lb + (1.0 - lb) * jax.nn.sigmoid(hf.astype(jnp.float32))
        log_f = jnp.log(f).reshape(B, T, HG_HEADS, HG_EXPAND)
        k_h = (1.0 - f).reshape(B, T, HG_HEADS, HG_EXPAND)
        q_h = jax.nn.silu(hq.astype(jnp.float32)).reshape(B, T, HG_HEADS, HG_EXPAND)
        v_h = hi.astype(jnp.float32).reshape(B, T, HG_HEADS, HG_HEAD_V)
        o_h = hgrn2_chunkwise(q_h, k_h, v_h, log_f)
        o_h = rms_norm(o_h, hgrn_norm_w[l].reshape(HG_HEADS, HG_HEAD_V)).reshape(B, T, HG_VAL_DIM)
        y_h = (o_h.astype(x.dtype) * jax.nn.silu(hg)) @ w_branch_hgrn[l]

        o_a = sliding_window_attention_with_sinks(
            aq.reshape(B, T, ATT_Q_HEADS, ATT_HEAD_DIM),
            ak.reshape(B, T, ATT_KV_HEADS, ATT_HEAD_DIM),
            av.reshape(B, T, ATT_KV_HEADS, ATT_HEAD_DIM),
            attn_sinks[l])
        y_a = (o_a * jax.nn.silu(ag)) @ w_branch_attn[l]

        merged = jax.nn.sigmoid(mh) * y_h + jax.nn.sigmoid(ma) * y_a
        x = x + merged @ w_out[l]
    return rms_norm(x, final_norm_w)
```

```cpp
#include <hip/hip_runtime.h>
#include <cstdio>
#include <cstdint>
namespace pg8 {
#define PG8_LAS __attribute__((address_space(3)))
typedef unsigned short bf16_t;
typedef short bf16x8 __attribute__((ext_vector_type(8)));
typedef float f32x4 __attribute__((ext_vector_type(4)));
typedef unsigned u32x4 __attribute__((ext_vector_type(4)));
constexpr int BM = 256, BK = 64, HALF = 128, HTB = HALF * BK * 2  , STAGE_BYTES = 8 * HTB, NXCD = 8, WGM = 8;

__host__ __device__ __forceinline__ int lds_byte(int r, int c) { const int st = (r >> 4) * 2 + (c >> 5), rr = r & 15, cc = c & 31, ob = rr * 64 + cc * 2; return st * 1024 + (ob ^ (((ob >> 9) & 1) << 5)); }
__host__ __device__ __forceinline__ void stage_rc(int b, int& R, int& C) { const int st = b / 1024, sb = b % 1024, swz = sb ^ (((sb >> 9) & 1) << 5); R = (st >> 1) * 16 + swz / 64; C = (st & 1) * 32 + (swz % 64) / 2; }
__host__ __device__ __forceinline__ int perm32(int rho) { const int n = rho >> 4, i = rho & 15; return 8 * (i >> 2) + 4 * n + (i & 3); }

struct Unit { int pm, pn; };
struct Gemm { const bf16_t* A; const bf16_t* Bt; int M, N, K; };

struct StaticOrder {
    int nM, nN, nwg, G, c;
    __host__ __device__ void init(int M, int N, int G_, int c_) { nM = M / BM; nN = N / BM; nwg = nM * nN; G = G_; c = c_; }
    __host__ __device__ bool next(int i, Unit& u) const {
        const long L = (long)i * G + c; if (L >= nwg) return false;
        int wgid = (int)L; { const int q = nwg / NXCD, r = nwg % NXCD, xcd = wgid % NXCD, off = wgid / NXCD; wgid = (xcd < r ? xcd * (q + 1) : r * (q + 1) + (xcd - r) * q) + off; }
        const int nig = WGM * nN, gid = wgid / nig, fm = gid * WGM, gsz = (nM - fm) < WGM ? (nM - fm) : WGM;
        u.pm = fm + ((wgid % nig) % gsz); u.pn = (wgid % nig) / gsz; return true;
    }
    __device__ __forceinline__ void a_ready(const Unit&) const {}
    __device__ __forceinline__ void done(const Unit&) const {}
};

typedef float f32x2c_t __attribute__((ext_vector_type(2))); typedef __bf16 bf16x2c_t __attribute__((ext_vector_type(2)));
__device__ __forceinline__ unsigned cvt_pk_bf16(float lo, float hi) { f32x2c_t v = {lo, hi}; bf16x2c_t b = __builtin_convertvector(v, bf16x2c_t); return __builtin_bit_cast(unsigned, b); }
typedef float f32x2 __attribute__((ext_vector_type(2)));
__device__ __forceinline__ f32x2 gelu_pk(f32x2 v) {
    const f32x2 av = __builtin_elementwise_abs(v), d = av * 0.2316418882f + 1.0f;
    f32x2 t; t.x = __builtin_amdgcn_rcpf(d.x); t.y = __builtin_amdgcn_rcpf(d.y);
    f32x2 q = t * 0.5307027145f + (-0.7265760135f); q = q * t + 0.7107068705f; q = q * t + (-0.142248368f); q = q * t + 0.127414796f; q = q * t;
    const f32x2 s = (v * v) * (-0.72134752044f);
    f32x2 e; e.x = __builtin_amdgcn_exp2f(s.x); e.y = __builtin_amdgcn_exp2f(s.y);
    const f32x2 m = v * (q * e), r = v - m;
    f32x2 o; o.x = v.x < 0.f ? m.x : r.x; o.y = v.y < 0.f ? m.y : r.y; return o;
}

template <int ACT  > struct EpiBf16 {
    static constexpr bool PERM = true, AFTER_DRAIN = false; static_assert(ACT == 0 || ACT == 1, "EpiBf16: ACT is 0 (none) or 1 (gelu_pk)");
    bf16_t* O; int ldc; const float* bias; int split_cols; size_t split_stride; float scale0;
    __device__ __forceinline__ void operator()(const f32x4 (&acc)[2][2][4][2], const Unit& u, int wr, int wc, int fr, int fq) const {
        const int row0 = u.pm * BM + wr * 64 + fr; int colt = u.pn * BM; bf16_t* base = O;
        float sc = 1.f; if (split_cols) { const int t = colt / split_cols; base += (size_t)t * split_stride; colt -= t * split_cols; if (t == 0) sc = scale0; }
        const int col0 = colt + wc * 32 + 8 * fq, bcol0 = u.pn * BM + wc * 32 + 8 * fq;
        f32x4 bv[2][2];
#pragma unroll
        for (int bj = 0; bj < 2; ++bj)
#pragma unroll
            for (int n = 0; n < 2; ++n) bv[bj][n] = bias ? *(const f32x4*)(bias + bcol0 + bj * HALF + 4 * n) : (f32x4){0.f, 0.f, 0.f, 0.f};
#pragma unroll
        for (int ai = 0; ai < 2; ++ai)
#pragma unroll
            for (int m = 0; m < 4; ++m) { bf16_t* rowp = base + (size_t)(row0 + ai * HALF + m * 16) * ldc + col0;
#pragma unroll
                for (int bj = 0; bj < 2; ++bj) { f32x4 v0 = acc[ai][bj][m][0] + bv[bj][0], v1 = acc[ai][bj][m][1] + bv[bj][1];
                    if (ACT == 1) { f32x2 a = gelu_pk((f32x2){v0[0], v0[1]}), b = gelu_pk((f32x2){v0[2], v0[3]}), c = gelu_pk((f32x2){v1[0], v1[1]}), d = gelu_pk((f32x2){v1[2], v1[3]});
                        v0 = (f32x4){a.x, a.y, b.x, b.y}; v1 = (f32x4){c.x, c.y, d.x, d.y}; }
                    v0 = v0 * sc; v1 = v1 * sc; u32x4 w; w.x = cvt_pk_bf16(v0[0], v0[1]); w.y = cvt_pk_bf16(v0[2], v0[3]); w.z = cvt_pk_bf16(v1[0], v1[1]); w.w = cvt_pk_bf16(v1[2], v1[3]);
                    *(u32x4*)(rowp + bj * HALF) = w; } }
    }
};

struct PanelStats {
    unsigned* xbuf;
    unsigned* cnt;
    unsigned* tmo;
    int ntn; float eps;
    unsigned code;
    __device__ __forceinline__ bool run(const f32x4 (&v)[2][2][4][2], const Unit& u, int wr, int wc, int fr, int fq, PG8_LAS unsigned char* lds, int wid, int lane) const {
        typedef float f32x2v __attribute__((ext_vector_type(2)));
        PG8_LAS f32x2v* P = (PG8_LAS f32x2v*)lds;
        PG8_LAS f32x2v* S = (PG8_LAS f32x2v*)(lds + 8192);
        PG8_LAS unsigned* flag = (PG8_LAS unsigned*)(lds + 8192 + 2048);
#pragma unroll
        for (int ai = 0; ai < 2; ++ai)
#pragma unroll
            for (int m = 0; m < 4; ++m) {
                float s = 0.f;
#pragma unroll
                for (int bj = 0; bj < 2; ++bj)
#pragma unroll
                    for (int n = 0; n < 2; ++n) { const f32x4 x = v[ai][bj][m][n]; s += (x[0] + x[1]) + (x[2] + x[3]); }
                s += __shfl_xor(s, 16); s += __shfl_xor(s, 32);
                const float mw = s * (1.0f / 64.0f); float q = 0.f;
#pragma unroll
                for (int bj = 0; bj < 2; ++bj)
#pragma unroll
                    for (int n = 0; n < 2; ++n) { const f32x4 d = v[ai][bj][m][n] - mw; q += (d[0] * d[0] + d[1] * d[1]) + (d[2] * d[2] + d[3] * d[3]); }
                q += __shfl_xor(q, 16); q += __shfl_xor(q, 32);
                if (fq == 0) P[(ai * HALF + wr * 64 + m * 16 + fr) * 4 + wc] = (f32x2v){mw, q};
            }
        asm volatile("s_waitcnt lgkmcnt(0)" ::: "memory"); __builtin_amdgcn_s_barrier(); asm volatile("" ::: "memory");
#if defined(BROKEN_EXCHANGE_NO_WAIT)
#warning BROKEN CONTROL BUILD: the row-statistics exchange does not wait; results are wrong by design
        if (blockIdx.x >= 64) { const long long t0_ = clock64(); while (clock64() - t0_ < 60000) __builtin_amdgcn_s_sleep(8); }
#endif
        const int row = wid * 32 + (lane & 31);
        if (lane < 32) {
            const f32x2v a = P[row * 4 + 0], b = P[row * 4 + 1], c = P[row * 4 + 2], d = P[row * 4 + 3];
            const float mt = (a.x + b.x + c.x + d.x) * 0.25f;
            const float da = a.x - mt, db = b.x - mt, dc = c.x - mt, dd = d.x - mt;
            const float m2 = (a.y + b.y) + (c.y + d.y) + 64.0f * ((da * da + db * db) + (dc * dc + dd * dd));
            unsigned long long* slot = (unsigned long long*)xbuf + ((size_t)(u.pm * BM + row) * 4 + u.pn);
            __hip_atomic_store(slot, ((unsigned long long)__float_as_uint(m2) << 32) | __float_as_uint(mt), __ATOMIC_RELAXED, __HIP_MEMORY_SCOPE_AGENT);
        }
        asm volatile("s_waitcnt vmcnt(0)" ::: "memory");
        if (lane == 0) __hip_atomic_fetch_add(cnt + 64 * u.pm, 1u, __ATOMIC_RELAXED, __HIP_MEMORY_SCOPE_AGENT);
        if (wid == 0) {
            bool dead = false; const unsigned long long t0 = __builtin_amdgcn_s_memrealtime(); const unsigned want = 8u * (unsigned)ntn;
            for (;;) {
#if defined(BROKEN_EXCHANGE_NO_WAIT)
                break;
#endif
                if ((unsigned)__builtin_amdgcn_readfirstlane(__hip_atomic_load(cnt + 64 * u.pm, __ATOMIC_RELAXED, __HIP_MEMORY_SCOPE_AGENT)) >= want) break;
                if (__builtin_amdgcn_s_memrealtime() - t0 > 2000000ull) {
                    if (lane == 0) { unsigned expect = 0u; __hip_atomic_compare_exchange_strong(tmo + 1, &expect, code | (unsigned)(u.pm & 0xff), __ATOMIC_RELAXED, __ATOMIC_RELAXED, __HIP_MEMORY_SCOPE_AGENT);
                                     __hip_atomic_store(tmo, 1u, __ATOMIC_RELAXED, __HIP_MEMORY_SCOPE_AGENT); }
                    dead = true; break; }
                __builtin_amdgcn_s_sleep(2);
            }
            __builtin_amdgcn_fence(__ATOMIC_ACQUIRE, "agent");
            if (lane == 0) flag[0] = dead ? 1u : 0u;
        }
        asm volatile("s_waitcnt vmcnt(0) lgkmcnt(0)" ::: "memory"); __builtin_amdgcn_s_barrier(); asm volatile("" ::: "memory");
        const bool bad = flag[0] != 0u;
        if (lane < 32) {
            const unsigned long long* slot = (const unsigned long long*)xbuf + (size_t)(u.pm * BM + row) * 4; float mt[4], m2[4]; float ms = 0.f;
#pragma unroll
            for (int t = 0; t < 4; ++t) { if (t < ntn) { const unsigned long long w = __hip_atomic_load(slot + t, __ATOMIC_RELAXED, __HIP_MEMORY_SCOPE_AGENT); mt[t] = __uint_as_float((unsigned)w); m2[t] = __uint_as_float((unsigned)(w >> 32)); } else { mt[t] = 0.f; m2[t] = 0.f; } ms += mt[t]; }
            const float mean = ms / (float)ntn; float q = 0.f;
#pragma unroll
            for (int t = 0; t < 4; ++t) if (t < ntn) { const float dm = mt[t] - mean; q += m2[t] + 256.0f * dm * dm; }
            S[row] = (f32x2v){mean, 1.0f / sqrtf(q / (256.0f * (float)ntn) + eps)};
        }
        asm volatile("s_waitcnt lgkmcnt(0)" ::: "memory"); __builtin_amdgcn_s_barrier(); asm volatile("" ::: "memory");
        return bad;
    }
};
struct EpiLnRes {
    static constexpr bool PERM = false, AFTER_DRAIN = true;
    const float* base; float* out; int ldc; const float* bias; PanelStats st; unsigned poison;
    __device__ __forceinline__ void fused(f32x4 (&acc)[2][2][4][2], const Unit& u, int wr, int wc, int fr, int fq, PG8_LAS unsigned char* lds, int wid, int lane) const {
        typedef float f32x2v __attribute__((ext_vector_type(2)));
        const PG8_LAS f32x2v* S = (const PG8_LAS f32x2v*)(lds + 8192);
        const int col0 = u.pn * BM + wc * 32 + 4 * fq;
#pragma unroll
        for (int bj = 0; bj < 2; ++bj)
#pragma unroll
            for (int n = 0; n < 2; ++n) { const f32x4 bv = bias ? *(const f32x4*)(bias + col0 + bj * HALF + n * 16) : (f32x4){0.f, 0.f, 0.f, 0.f};
#pragma unroll
                for (int ai = 0; ai < 2; ++ai)
#pragma unroll
                    for (int m = 0; m < 4; ++m) acc[ai][bj][m][n] += bv; }
        f32x4 pre[4][2][2];
#pragma unroll
        for (int m = 0; m < 4; ++m) { const size_t off = (size_t)(u.pm * BM + wr * 64 + m * 16 + fr) * ldc + col0;
#pragma unroll
            for (int bj = 0; bj < 2; ++bj)
#pragma unroll
                for (int n = 0; n < 2; ++n) pre[m][bj][n] = *(const f32x4*)(base + off + bj * HALF + n * 16); }
        const bool bad = st.run(acc, u, wr, wc, fr, fq, lds, wid, lane) || poison != 0u;
        const float qnan = __builtin_nanf("");
#pragma unroll
        for (int ai = 0; ai < 2; ++ai)
#pragma unroll
            for (int m = 0; m < 4; ++m) { const int r = ai * HALF + wr * 64 + m * 16 + fr; const f32x2v sr = S[r]; const size_t off = (size_t)(u.pm * BM + r) * ldc + col0;
#pragma unroll
                for (int bj = 0; bj < 2; ++bj)
#pragma unroll
                    for (int n = 0; n < 2; ++n) { const f32x4 bs = ai == 0 ? pre[m][bj][n] : *(const f32x4*)(base + off + bj * HALF + n * 16); f32x4 o = bs + (acc[ai][bj][m][n] - sr.x) * sr.y;
                        if (bad) o = (f32x4){qnan, qnan, qnan, qnan}; *(f32x4*)(out + off + bj * HALF + n * 16) = o; }
                if (m & 1) asm volatile("" ::: "memory"); }
    }
};
struct EpiLnResLn {
    static constexpr bool PERM = false, AFTER_DRAIN = true;
    const float* base; float* out; bf16_t* xn; int ldc; const float* bias; PanelStats st1, st2; unsigned poison;
    __device__ __forceinline__ void fused(f32x4 (&acc)[2][2][4][2], const Unit& u, int wr, int wc, int fr, int fq, PG8_LAS unsigned char* lds, int wid, int lane) const {
        typedef float f32x2v __attribute__((ext_vector_type(2))); typedef unsigned u32x2v __attribute__((ext_vector_type(2)));
        const PG8_LAS f32x2v* S = (const PG8_LAS f32x2v*)(lds + 8192);
        const int col0 = u.pn * BM + wc * 32 + 4 * fq;
#pragma unroll
        for (int bj = 0; bj < 2; ++bj)
#pragma unroll
            for (int n = 0; n < 2; ++n) { const f32x4 bv = bias ? *(const f32x4*)(bias + col0 + bj * HALF + n * 16) : (f32x4){0.f, 0.f, 0.f, 0.f};
#pragma unroll
                for (int ai = 0; ai < 2; ++ai)
#pragma unroll
                    for (int m = 0; m < 4; ++m) acc[ai][bj][m][n] += bv; }
        bool bad = st1.run(acc, u, wr, wc, fr, fq, lds, wid, lane) || poison != 0u;
        const float qnan = __builtin_nanf("");
#pragma unroll
        for (int ai = 0; ai < 2; ++ai)
#pragma unroll
            for (int m = 0; m < 4; ++m) { const int r = ai * HALF + wr * 64 + m * 16 + fr; const f32x2v sr = S[r]; const size_t off = (size_t)(u.pm * BM + r) * ldc + col0;
#pragma unroll
                for (int bj = 0; bj < 2; ++bj)
#pragma unroll
                    for (int n = 0; n < 2; ++n) { const f32x4 bs = *(const f32x4*)(base + off + bj * HALF + n * 16); acc[ai][bj][m][n] = bs + (acc[ai][bj][m][n] - sr.x) * sr.y; }
                asm volatile("" : "+v"(acc[ai][0][m][0]), "+v"(acc[ai][0][m][1]), "+v"(acc[ai][1][m][0]), "+v"(acc[ai][1][m][1]));
                if (m & 1) asm volatile("" ::: "memory"); }
        const bool bad1 = bad;
        bad = st2.run(acc, u, wr, wc, fr, fq, lds, wid, lane) || bad;
#pragma unroll
        for (int ai = 0; ai < 2; ++ai)
#pragma unroll
            for (int m = 0; m < 4; ++m) { const int r = ai * HALF + wr * 64 + m * 16 + fr; const f32x2v sr = S[r]; const size_t off = (size_t)(u.pm * BM + r) * ldc + col0;
#pragma unroll
                for (int bj = 0; bj < 2; ++bj)
#pragma unroll
                    for (int n = 0; n < 2; ++n) { const f32x4 x1 = acc[ai][bj][m][n]; *(f32x4*)(out + off + bj * HALF + n * 16) = bad1 ? (f32x4){qnan, qnan, qnan, qnan} : x1;
                        const f32x4 o = (x1 - sr.x) * sr.y; u32x2v w; w.x = cvt_pk_bf16(o[0], o[1]); w.y = cvt_pk_bf16(o[2], o[3]);
                        if (bad) { w.x = 0x7fc07fc0u; w.y = 0x7fc07fc0u; } *(u32x2v*)(xn + off + bj * HALF + n * 16) = w; }
                asm volatile("" ::: "memory"); }
    }
};

template <class Epi, class Sched, bool ALIGN_EPI = false, bool SP2 = false>
__device__ __forceinline__ void gemm_phase(PG8_LAS unsigned char* lds, const Gemm g, const Sched& S, const Epi& E) {
    const int tid = threadIdx.x, wid = __builtin_amdgcn_readfirstlane(tid >> 6), lane = tid & 63, wr = wid >> 2, wc = wid & 3, fr = lane & 15, fq = lane >> 4;
    const int K = g.K, nt = K / BK;
    unsigned voffA[2], voffB[2];
#pragma unroll
    for (int i = 0; i < 2; ++i) { int R, C; stage_rc(tid * 16 + i * 8192, R, C); const int Rb = Epi::PERM ? ((R & ~31) + perm32(R & 31)) : R;
        voffA[i] = (unsigned)(R * K + C) * 2u; voffB[i] = (unsigned)(Rb * K + C) * 2u; }
    const size_t kstep = (size_t)(BK * 2);
    const size_t hstep = (size_t)HALF * K * 2;
    const size_t tstep = 2 * hstep;
    const unsigned ldsw = (unsigned)wid * 1024u;
    const int aoff = lds_byte(wr * 64 + fr, fq * 8), boff = lds_byte(wc * 32 + fr, fq * 8);
#define PG8_SA(b, h) (((b) * 2 + (h)) * HTB)
#define PG8_SB(b, h) ((4 + (b) * 2 + (h)) * HTB)
#define PG8_STAGE(bufoff, gbase, voff) do { _Pragma("unroll") for (int _i = 0; _i < 2; ++_i) \
        __builtin_amdgcn_global_load_lds((const unsigned*)((const char*)(gbase) + (voff)[_i]), (PG8_LAS unsigned*)(lds + (bufoff) + ldsw + _i * 8192), 16, 0, 0); } while (0)
#define PG8_LDA(dst, b, h) do { _Pragma("unroll") for (int m = 0; m < 4; ++m) _Pragma("unroll") for (int k = 0; k < 2; ++k) dst[m][k] = *(const PG8_LAS bf16x8*)(lds + PG8_SA(b, h) + aoff + m * 2048 + k * 1024); } while (0)
#define PG8_LDB(dst, b, h) do { _Pragma("unroll") for (int n = 0; n < 2; ++n) _Pragma("unroll") for (int k = 0; k < 2; ++k) dst[n][k] = *(const PG8_LAS bf16x8*)(lds + PG8_SB(b, h) + boff + n * 2048 + k * 1024); } while (0)
#define PG8_MMA(ai, bj, At, Bt) do { __builtin_amdgcn_s_setprio(1); _Pragma("unroll") for (int m = 0; m < 4; ++m) _Pragma("unroll") for (int n = 0; n < 2; ++n) _Pragma("unroll") for (int k = 0; k < 2; ++k) \
        acc[ai][bj][m][n] = __builtin_amdgcn_mfma_f32_16x16x32_bf16(Bt[n][k], At[m][k], acc[ai][bj][m][n], 0, 0, 0); __builtin_amdgcn_s_setprio(0); } while (0)
#define PG8_WAIT_V(n) asm volatile("s_waitcnt vmcnt(" #n ")" ::: "memory")
#define PG8_WAIT_L(n) asm volatile("s_waitcnt lgkmcnt(" #n ")" ::: "memory")
#define PG8_BAR __builtin_amdgcn_s_barrier()
#define PG8_SCHED __builtin_amdgcn_sched_barrier(0)
    Unit cur, nxt; int ui = 0;
    if (!S.next(0, cur)) return;
    f32x4 acc[2][2][4][2];
#pragma unroll
    for (int a = 0; a < 2; ++a)
#pragma unroll
        for (int b = 0; b < 2; ++b)
#pragma unroll
            for (int m = 0; m < 4; ++m)
#pragma unroll
                for (int n = 0; n < 2; ++n) acc[a][b][m][n] = (f32x4){0.f, 0.f, 0.f, 0.f};
    bf16x8 At[4][2], B0[2][2], B1[2][2];
    const char* cA = (const char*)g.A + (size_t)cur.pm * tstep; const char* cB = (const char*)g.Bt + (size_t)cur.pn * tstep;
    S.a_ready(cur);
    if constexpr (SP2) {
        PG8_STAGE(PG8_SB(0, 0), cB, voffB); PG8_STAGE(PG8_SB(0, 1), cB + hstep, voffB); PG8_STAGE(PG8_SA(0, 0), cA, voffA); PG8_STAGE(PG8_SA(0, 1), cA + hstep, voffA);
        if (wr == 1) PG8_BAR;
        PG8_WAIT_V(2); PG8_BAR;
        PG8_STAGE(PG8_SB(1, 0), cB + kstep, voffB); PG8_STAGE(PG8_SA(1, 0), cA + kstep, voffA); PG8_STAGE(PG8_SB(1, 1), cB + hstep + kstep, voffB);
        PG8_WAIT_V(6); PG8_BAR;
    } else {
        PG8_STAGE(PG8_SB(0, 0), cB, voffB); PG8_STAGE(PG8_SA(0, 0), cA, voffA); PG8_STAGE(PG8_SB(0, 1), cB + hstep, voffB); PG8_STAGE(PG8_SA(0, 1), cA + hstep, voffA);
        if (wr == 1) PG8_BAR;
        PG8_WAIT_V(4); PG8_BAR;
        PG8_STAGE(PG8_SB(1, 0), cB + kstep, voffB); PG8_STAGE(PG8_SA(1, 0), cA + kstep, voffA); PG8_STAGE(PG8_SB(1, 1), cB + hstep + kstep, voffB);
        PG8_WAIT_V(6); PG8_BAR;
    }
    for (;;) {
        const bool has_next = S.next(ui + 1, nxt);
        const char* nA = has_next ? (const char*)g.A + (size_t)nxt.pm * tstep : cA; const char* nB = has_next ? (const char*)g.Bt + (size_t)nxt.pn * tstep : cB;
        for (int t = 0; t < nt; t += 2) {
            const bool last = (t == nt - 2);
            const char* a1 = cA + (size_t)(t + 1) * kstep;
            const char* a2 = last ? nA : cA + (size_t)(t + 2) * kstep; const char* b2 = last ? nB : cB + (size_t)(t + 2) * kstep;
            const char* a3 = a2 + kstep; const char* b3 = b2 + kstep;
            if (last && has_next) S.a_ready(nxt);
            if constexpr (SP2) {
            PG8_LDB(B0, 0, 0); PG8_LDB(B1, 0, 1); PG8_SCHED; PG8_LDA(At, 0, 0); PG8_STAGE(PG8_SA(1, 1), a1 + hstep, voffA);
            PG8_WAIT_V(8); PG8_WAIT_L(0); PG8_BAR; PG8_MMA(0, 0, At, B0); PG8_MMA(0, 1, At, B1); PG8_BAR; PG8_SCHED;
            PG8_LDA(At, 0, 1); PG8_STAGE(PG8_SB(0, 0), b2, voffB); PG8_STAGE(PG8_SB(0, 1), b2 + hstep, voffB); PG8_STAGE(PG8_SA(0, 0), a2, voffA);
            PG8_WAIT_V(8); PG8_WAIT_L(0); PG8_BAR; PG8_MMA(1, 0, At, B0); PG8_MMA(1, 1, At, B1); PG8_BAR; PG8_SCHED;
            PG8_LDB(B0, 1, 0); PG8_LDB(B1, 1, 1); PG8_SCHED; PG8_LDA(At, 1, 0); PG8_STAGE(PG8_SA(0, 1), a2 + hstep, voffA);
            PG8_WAIT_V(8); PG8_WAIT_L(0); PG8_BAR; PG8_MMA(0, 0, At, B0); PG8_MMA(0, 1, At, B1); PG8_BAR; PG8_SCHED;
            PG8_LDA(At, 1, 1); PG8_STAGE(PG8_SB(1, 0), b3, voffB); PG8_STAGE(PG8_SB(1, 1), b3 + hstep, voffB); PG8_STAGE(PG8_SA(1, 0), a3, voffA);
            PG8_WAIT_V(8); PG8_WAIT_L(0); PG8_BAR; PG8_MMA(1, 0, At, B0); PG8_MMA(1, 1, At, B1); PG8_BAR; PG8_SCHED;
            } else {
            PG8_LDB(B0, 0, 0); PG8_SCHED; PG8_LDA(At, 0, 0); PG8_STAGE(PG8_SA(1, 1), a1 + hstep, voffA);
            PG8_WAIT_L(8); PG8_BAR; PG8_WAIT_L(0); PG8_MMA(0, 0, At, B0); PG8_BAR; PG8_SCHED;
            PG8_LDB(B1, 0, 1); PG8_STAGE(PG8_SB(0, 0), b2, voffB);
            PG8_BAR; PG8_WAIT_L(0); PG8_MMA(0, 1, At, B1); PG8_BAR;
            PG8_LDA(At, 0, 1); PG8_STAGE(PG8_SA(0, 0), a2, voffA);
            PG8_BAR; PG8_WAIT_L(0); PG8_MMA(1, 0, At, B0); PG8_BAR; PG8_SCHED;
            PG8_STAGE(PG8_SB(0, 1), b2 + hstep, voffB);
            PG8_WAIT_V(6); PG8_BAR; PG8_MMA(1, 1, At, B1); PG8_BAR;
            PG8_LDB(B0, 1, 0); PG8_SCHED; PG8_LDA(At, 1, 0); PG8_STAGE(PG8_SA(0, 1), a2 + hstep, voffA);
            PG8_WAIT_L(8); PG8_BAR; PG8_WAIT_L(0); PG8_MMA(0, 0, At, B0); PG8_BAR; PG8_SCHED;
            PG8_LDB(B1, 1, 1); PG8_STAGE(PG8_SB(1, 0), b3, voffB);
            PG8_BAR; PG8_WAIT_L(0); PG8_MMA(0, 1, At, B1); PG8_BAR;
            PG8_LDA(At, 1, 1); PG8_STAGE(PG8_SA(1, 0), a3, voffA);
            PG8_BAR; PG8_WAIT_L(0); PG8_MMA(1, 0, At, B0); PG8_BAR; PG8_SCHED;
            PG8_STAGE(PG8_SB(1, 1), b3 + hstep, voffB);
            PG8_WAIT_V(6); PG8_BAR; PG8_MMA(1, 1, At, B1); PG8_BAR;
            }
        }
        if constexpr (ALIGN_EPI) { if (wr == 0) PG8_BAR; }
        if constexpr (!Epi::AFTER_DRAIN) { E(acc, cur, wr, wc, fr, fq); S.done(cur); }
        if (!has_next) break;
#pragma unroll
        for (int a = 0; a < 2; ++a)
#pragma unroll
            for (int b = 0; b < 2; ++b)
#pragma unroll
                for (int m = 0; m < 4; ++m)
#pragma unroll
                    for (int n = 0; n < 2; ++n) acc[a][b][m][n] = (f32x4){0.f, 0.f, 0.f, 0.f};
        cur = nxt; cA = nA; cB = nB; ++ui;
        if constexpr (ALIGN_EPI) { if (wr == 1) PG8_BAR; }
    }
    PG8_WAIT_V(0);
    if constexpr (!ALIGN_EPI) { if (wr == 0) PG8_BAR; }
    PG8_BAR;
    if constexpr (Epi::AFTER_DRAIN) { E.fused(acc, cur, wr, wc, fr, fq, lds, wid, lane); S.done(cur); }
#undef PG8_SA
#undef PG8_SB
#undef PG8_STAGE
#undef PG8_LDA
#undef PG8_LDB
#undef PG8_MMA
#undef PG8_WAIT_V
#undef PG8_WAIT_L
#undef PG8_BAR
#undef PG8_SCHED
}
}

#ifndef PG8_SP2
#define PG8_SP2 true
#endif
#ifndef PG8_ALIGN
#define PG8_ALIGN true
#endif
constexpr int NWAVES = 8;
constexpr int BATCH = 2, T = 8192, D = 1024, M = BATCH * T, DIN = 8704;
constexpr int HG_H = 8, AT_HQ = 16;
constexpr float EPS = 1e-6f;
constexpr float LOG2E = 1.4426950408889634f;
constexpr float C2 = 0.125f * LOG2E;
constexpr int NT_A = 26, NT_B = 8;
constexpr size_t MiB = 1u << 20;
constexpr size_t WS_CTL = 0, CTL_ZERO_BYTES = 1 * MiB;
constexpr size_t WS_WBH = 1 * MiB, WS_WBA = 3 * MiB, WS_WOUT = 5 * MiB, WS_WIN = 7 * MiB;
constexpr size_t WS_QH = 24 * MiB, WS_GH = 56 * MiB, WS_VH = 88 * MiB, WS_SG = 120 * MiB, WS_AQ = 152 * MiB, WS_AK = 184 * MiB, WS_AV = 192 * MiB, WS_AG = 200 * MiB, WS_MISC = 232 * MiB, WS_END = 256 * MiB;
constexpr size_t WS_MH = WS_GH, WS_MA = WS_VH, WS_YH = WS_SG, WS_YA = WS_AG, WS_MERGED = WS_QH;
constexpr int CW_TMO = 0, CW_CODE = 1, CW_BAR = 4096;
constexpr int RING_OFF = 0, RING_BYTES = 131072;
constexpr int LDSCTL_OFF = RING_BYTES, MISC_OFF = LDSCTL_OFF + 320;
constexpr int LDS_BYTES = 147456;
namespace pg8 {
enum { K_NONE = 0, K_SILU = 1, K_SIG = 2, K_LOGF = 3, K_SCALE = 4 };
typedef _Float16 f16x2 __attribute__((ext_vector_type(2)));
__device__ __forceinline__ float act_sigmoid(float x) { return __builtin_amdgcn_rcpf(1.f + __builtin_amdgcn_exp2f(-1.4426950408889634f * x)); }
template <int KIND> __device__ __forceinline__ unsigned act_pk(float a, float b, float la, float lb) {
    if (KIND == K_NONE) return cvt_pk_bf16(a, b);
    if (KIND == K_SCALE) return cvt_pk_bf16(a * (0.125f * 1.4426950408889634f), b * (0.125f * 1.4426950408889634f));
    if (KIND == K_SILU) return cvt_pk_bf16(a * act_sigmoid(a), b * act_sigmoid(b));
    if (KIND == K_SIG) return cvt_pk_bf16(act_sigmoid(a), act_sigmoid(b));
    const float fa = la + (1.f - la) * act_sigmoid(a), fb = lb + (1.f - lb) * act_sigmoid(b);
    f16x2 h; h.x = (_Float16)__builtin_amdgcn_logf(fa); h.y = (_Float16)__builtin_amdgcn_logf(fb); return __builtin_bit_cast(unsigned, h);
}
struct EpiProj {
    static constexpr bool PERM = true, AFTER_DRAIN = false;
    unsigned char* ws; const float* lb; int pn0;
    template <int KIND> __device__ __forceinline__ void tile(const f32x4 (&acc)[2][2][4][2], bf16_t* base, int ld, int row0, int col0) const {
#pragma unroll
        for (int bj = 0; bj < 2; ++bj) {
            f32x4 l0 = (f32x4){0.f, 0.f, 0.f, 0.f}, l1 = l0;
            if (KIND == K_LOGF) { l0 = *(const f32x4*)(lb + col0 + bj * HALF); l1 = *(const f32x4*)(lb + col0 + bj * HALF + 4); }
#pragma unroll
            for (int ai = 0; ai < 2; ++ai)
#pragma unroll
                for (int m = 0; m < 4; ++m) {
                    const f32x4 v0 = acc[ai][bj][m][0], v1 = acc[ai][bj][m][1];
                    u32x4 w; w.x = act_pk<KIND>(v0[0], v0[1], l0[0], l0[1]); w.y = act_pk<KIND>(v0[2], v0[3], l0[2], l0[3]);
                    w.z = act_pk<KIND>(v1[0], v1[1], l1[0], l1[1]); w.w = act_pk<KIND>(v1[2], v1[3], l1[2], l1[3]);
                    *(u32x4*)(base + (size_t)(row0 + ai * HALF + m * 16) * ld + col0 + bj * HALF) = w;
                }
        }
    }
    __device__ __forceinline__ void operator()(const f32x4 (&acc)[2][2][4][2], const Unit& u, int wr, int wc, int fr, int fq) const {
        const int ct = u.pn + pn0, row0 = u.pm * BM + wr * 64 + fr, cl = wc * 32 + 8 * fq;
        if (ct < 4)        tile<K_SILU>(acc, (bf16_t*)(ws + WS_QH), 1024, row0, ct * 256 + cl);
        else if (ct < 8)   tile<K_LOGF>(acc, (bf16_t*)(ws + WS_GH), 1024, row0, (ct - 4) * 256 + cl);
        else if (ct < 12)  tile<K_NONE>(acc, (bf16_t*)(ws + WS_VH), 1024, row0, (ct - 8) * 256 + cl);
        else if (ct < 16)  tile<K_SILU>(acc, (bf16_t*)(ws + WS_SG), 1024, row0, (ct - 12) * 256 + cl);
        else if (ct < 20)  tile<K_SCALE>(acc, (bf16_t*)(ws + WS_AQ), 1024, row0, (ct - 16) * 256 + cl);
        else if (ct == 20) tile<K_NONE>(acc, (bf16_t*)(ws + WS_AK), 256, row0, cl);
        else if (ct == 21) tile<K_NONE>(acc, (bf16_t*)(ws + WS_AV), 256, row0, cl);
        else if (ct < 26)  tile<K_SILU>(acc, (bf16_t*)(ws + WS_AG), 1024, row0, (ct - 22) * 256 + cl);
        else if (ct < 30)  tile<K_SIG>(acc, (bf16_t*)(ws + WS_MH), 1024, row0, (ct - 26) * 256 + cl);
        else               tile<K_SIG>(acc, (bf16_t*)(ws + WS_MA), 1024, row0, (ct - 30) * 256 + cl);
    }
};
struct EpiResF32 {
    static constexpr bool PERM = false, AFTER_DRAIN = false;
    const float* base; float* out; int ldc;
    __device__ __forceinline__ void operator()(const f32x4 (&acc)[2][2][4][2], const Unit& u, int wr, int wc, int fr, int fq) const {
        const int row0 = u.pm * BM + wr * 64 + fr, col0 = u.pn * BM + wc * 32 + 4 * fq;
#pragma unroll
        for (int ai = 0; ai < 2; ++ai)
#pragma unroll
            for (int m = 0; m < 4; ++m) { const size_t off = (size_t)(row0 + ai * HALF + m * 16) * ldc + col0;
#pragma unroll
                for (int bj = 0; bj < 2; ++bj)
#pragma unroll
                    for (int n = 0; n < 2; ++n) { const f32x4 bs = *(const f32x4*)(base + off + bj * HALF + n * 16); *(f32x4*)(out + off + bj * HALF + n * 16) = bs + acc[ai][bj][m][n]; } }
    }
};
}
#define GAS __attribute__((address_space(1)))
#define LAS __attribute__((address_space(3)))
typedef unsigned short bf16;
typedef unsigned v4u __attribute__((ext_vector_type(4)));
typedef float f32x4 __attribute__((ext_vector_type(4)));
typedef short bf16x8 __attribute__((ext_vector_type(8)));
typedef GAS unsigned gu32;
typedef GAS unsigned long long gu64;
#define RLX_AGENT __ATOMIC_RELAXED, __HIP_MEMORY_SCOPE_AGENT
#define LDS_WAIT() asm volatile("s_waitcnt lgkmcnt(0)" ::: "memory")
#define VM_WAIT() asm volatile("s_waitcnt vmcnt(0)" ::: "memory")
__device__ __forceinline__ unsigned long long rt() { return __builtin_amdgcn_s_memrealtime(); }
__device__ __forceinline__ unsigned f2bf(float f) { unsigned u = __builtin_bit_cast(unsigned, f); return (u + 0x7fffu + ((u >> 16) & 1u)) >> 16; }
__device__ __forceinline__ unsigned pk2(float lo, float hi) { return f2bf(lo) | (f2bf(hi) << 16); }

#define XB_TMO      128
#define XB_XCNT(j)  (256  + 64 * (j))
#define XB_XSUB(j)  (1280 + 64 * (j))
#define XB_XGEN(j)  (2304 + 64 * (j))
#define XB_TOP      3328
#define XB_TOPGEN   3392
#define XCD_BAR_WORDS 3456
#define XB_SPIN_CAP (1u << 18)

__device__ __forceinline__ unsigned xb_ld(unsigned* p)              { return __hip_atomic_load(p, __ATOMIC_RELAXED, __HIP_MEMORY_SCOPE_AGENT); }
__device__ __forceinline__ unsigned xb_add(unsigned* p, unsigned v) { return __hip_atomic_fetch_add(p, v, __ATOMIC_RELAXED, __HIP_MEMORY_SCOPE_AGENT); }
__device__ __forceinline__ unsigned xb_xcc_id() { return (unsigned)__builtin_amdgcn_s_getreg((3 << 11) | 20) & 0xFu; }
#define XB_SPIN(cond, bar) do { unsigned _sp = 0; while (cond) { __builtin_amdgcn_s_sleep(1); \
    if ((++_sp & 255u) == 0u) { if (xb_ld(&(bar)[XB_TMO])) break; if (_sp > XB_SPIN_CAP) { atomicAdd(&(bar)[XB_TMO], 1u); break; } } } } while (0)

struct XcdBarrier {
    unsigned* bar; unsigned x;
    volatile LAS unsigned* st;
};

__device__ __forceinline__ XcdBarrier xcd_barrier_post(unsigned* bar, volatile LAS unsigned* st) {
    XcdBarrier b; b.bar = bar; b.x = xb_xcc_id(); b.st = st;
    if (threadIdx.x == 0) (void)xb_add(&bar[XB_XCNT(b.x)], 1u);
    return b;
}
__device__ __forceinline__ void xcd_barrier_complete(unsigned* bar, unsigned x, unsigned& nloc, unsigned& nx) {
    const unsigned G = gridDim.x * gridDim.y * gridDim.z;
    unsigned sum, cnt, mine, sp = 0u;
    for (;;) {
        sum = 0u; cnt = 0u; mine = 0u;
#pragma unroll
        for (unsigned j = 0; j < 16; ++j) { const unsigned c = xb_ld(&bar[XB_XCNT(j)]); sum += c; cnt += (c > 0u) ? 1u : 0u; mine = (j == x) ? c : mine; }
        if (sum == G) break;
        __builtin_amdgcn_s_sleep(1);
        if ((++sp & 255u) == 0u) { if (xb_ld(&bar[XB_TMO])) break; if (sp > XB_SPIN_CAP) { atomicAdd(&bar[XB_TMO], 1u); break; } }
    }
    nloc = mine > 0u ? mine : 1u; nx = cnt > 0u ? cnt : 1u;
}

__device__ __forceinline__ void xcd_barrier(const XcdBarrier& b) {
    asm volatile("s_waitcnt vmcnt(0)" ::: "memory");
    __syncthreads();
    if (threadIdx.x == 0) {
        unsigned* bar = b.bar;
        __builtin_amdgcn_s_waitcnt(0);
        unsigned nloc = b.st[0], nx = b.st[1];
        if (nloc == 0u) { xcd_barrier_complete(bar, b.x, nloc, nx); b.st[0] = nloc; b.st[1] = nx; }
        const unsigned old = xb_add(&bar[XB_XSUB(b.x)], 1u);
        const unsigned gen = old / nloc;
        if (old + 1u == (gen + 1u) * nloc) {
            __builtin_amdgcn_fence(__ATOMIC_RELEASE, "agent");
            asm volatile("s_waitcnt vmcnt(0)" ::: "memory");
            const unsigned og = xb_add(&bar[XB_TOP], 1u);
            const unsigned tg = og / nx;
            if (og + 1u == (tg + 1u) * nx) xb_add(&bar[XB_TOPGEN], 1u);
            else XB_SPIN(xb_ld(&bar[XB_TOPGEN]) == tg, bar);
            __builtin_amdgcn_fence(__ATOMIC_ACQUIRE, "agent");
            xb_add(&bar[XB_XGEN(b.x)], 1u);
            asm volatile("s_waitcnt vmcnt(0)" ::: "memory");
        } else {
            XB_SPIN(xb_ld(&bar[XB_XGEN(b.x)]) == gen, bar);
            __builtin_amdgcn_fence(__ATOMIC_ACQUIRE, "agent");
            asm volatile("s_waitcnt vmcnt(0)" ::: "memory");
        }
    }
    __syncthreads();
}
__device__ __forceinline__ float wave_sum(float v) {
#pragma unroll
    for (int o = 1; o < 64; o <<= 1) v += __shfl_xor(v, o);
    return v;
}
__device__ __forceinline__ void p0_transpose_item(const float* W, int K, int N, bf16* WT, int row_off, LAS float* scr, int item, int lane) {
    const int nblk = N / 32, kb = item / nblk, nb = item % nblk, k0 = 64 * kb, n0 = 32 * nb;
#pragma unroll 8
    for (int i = 0; i < 32; ++i) { const int kk = 2 * i + (lane >> 5); scr[kk * 33 + (lane & 31)] = W[(size_t)(k0 + kk) * N + n0 + (lane & 31)]; }
    LDS_WAIT(); asm volatile("" ::: "memory");
    const int c = lane & 7;
#pragma unroll
    for (int j = 0; j < 4; ++j) { const int n = (lane >> 3) + 8 * j; const LAS float* s = scr + (8 * c) * 33 + n;
        v4u o; o.x = pk2(s[0 * 33], s[1 * 33]); o.y = pk2(s[2 * 33], s[3 * 33]); o.z = pk2(s[4 * 33], s[5 * 33]); o.w = pk2(s[6 * 33], s[7 * 33]);
        *(GAS v4u*)(WT + (size_t)(row_off + n0 + n) * K + k0 + 8 * c) = o; }
    LDS_WAIT(); asm volatile("" ::: "memory");
}
struct Frame {
    LAS unsigned char* lds;
    volatile LAS unsigned* MISC;
    gu32* ctl;
    int tid, lane, wave, vcu, G;
};
__device__ __forceinline__ float bf_lo(unsigned w) { return __uint_as_float(w << 16); }
__device__ __forceinline__ float bf_hi(unsigned w) { return __uint_as_float(w & 0xffff0000u); }
__device__ __forceinline__ float bf2f(bf16 h) { return __uint_as_float((unsigned)h << 16); }
typedef _Float16 h16x2 __attribute__((ext_vector_type(2)));
__device__ __forceinline__ float h_lo(unsigned w) { return (float)__builtin_bit_cast(h16x2, w).x; }
__device__ __forceinline__ float h_hi(unsigned w) { return (float)__builtin_bit_cast(h16x2, w).y; }

__device__ __forceinline__ void rms_row_to_bf16(int lane, const float* xrow, const float* w, bf16* orow) {
    const GAS f32x4* xr = (const GAS f32x4*)xrow + lane; const GAS f32x4* wr = (const GAS f32x4*)w + lane;
    f32x4 v[4]; float s = 0.f;
#pragma unroll
    for (int j = 0; j < 4; ++j) { v[j] = xr[64 * j]; s += (v[j].x * v[j].x + v[j].y * v[j].y) + (v[j].z * v[j].z + v[j].w * v[j].w); }
    const float rstd = 1.f / sqrtf(wave_sum(s) * (1.f / D) + EPS);
    GAS unsigned long long* o8 = (GAS unsigned long long*)orow + lane;
#pragma unroll
    for (int j = 0; j < 4; ++j) { const f32x4 g = wr[64 * j];
        o8[64 * j] = (unsigned long long)pk2(v[j].x * rstd * g.x, v[j].y * rstd * g.y) | ((unsigned long long)pk2(v[j].z * rstd * g.z, v[j].w * rstd * g.w) << 32); }
}
__device__ __forceinline__ void rms_row_f32(int lane, const float* xrow, const float* w, float* orow) {
    const GAS f32x4* xr = (const GAS f32x4*)xrow + lane; const GAS f32x4* wr = (const GAS f32x4*)w + lane;
    f32x4 v[4]; float s = 0.f;
#pragma unroll
    for (int j = 0; j < 4; ++j) { v[j] = xr[64 * j]; s += (v[j].x * v[j].x + v[j].y * v[j].y) + (v[j].z * v[j].z + v[j].w * v[j].w); }
    const float rstd = 1.f / sqrtf(wave_sum(s) * (1.f / D) + EPS);
    GAS f32x4* o = (GAS f32x4*)orow + lane;
#pragma unroll
    for (int j = 0; j < 4; ++j) { const f32x4 g = wr[64 * j]; o[64 * j] = v[j] * rstd * g; }
}

__device__ __forceinline__ void hgrn_naive(Frame& F, unsigned char* ws, const float* hnw, int bh) {
    const int b = bh >> 3, h = bh & 7, tid = F.tid, lane = F.lane, w = F.wave, vi = lane & 15, dq = lane >> 4;
    LAS float* qs = (LAS float*)(F.lds + RING_OFF); LAS float* fs = qs + 2048; LAS float* ks = fs + 2048; LAS float* vs = ks + 2048; LAS float* os = vs + 2048;
    bf16* QH = (bf16*)(ws + WS_QH); const bf16* GH = (const bf16*)(ws + WS_GH); const bf16* VH = (const bf16*)(ws + WS_VH); const bf16* SG = (const bf16*)(ws + WS_SG);
    float S[32];
#pragma unroll
    for (int i = 0; i < 32; ++i) S[i] = 0.f;
    const int tt = tid >> 5, c4 = (tid & 31) * 4;
    for (int t0 = 0; t0 < T; t0 += 16) {
        const size_t off = ((size_t)b * T + t0 + tt) * 1024 + h * 128 + c4;
        { const uint2 qw = *(const uint2*)(QH + off), gw = *(const uint2*)(GH + off), vw = *(const uint2*)(VH + off);
          const f32x4 q4 = {bf_lo(qw.x), bf_hi(qw.x), bf_lo(qw.y), bf_hi(qw.y)}, v4 = {bf_lo(vw.x), bf_hi(vw.x), bf_lo(vw.y), bf_hi(vw.y)};
          f32x4 f4 = {__builtin_amdgcn_exp2f(h_lo(gw.x)), __builtin_amdgcn_exp2f(h_hi(gw.x)), __builtin_amdgcn_exp2f(h_lo(gw.y)), __builtin_amdgcn_exp2f(h_hi(gw.y))};
          const f32x4 k4 = 1.f - f4;
          *(LAS f32x4*)(qs + tt * 128 + c4) = q4; *(LAS f32x4*)(fs + tt * 128 + c4) = f4; *(LAS f32x4*)(ks + tt * 128 + c4) = k4; *(LAS f32x4*)(vs + tt * 128 + c4) = v4; }
        __syncthreads();
        for (int s = 0; s < 16; ++s) {
            const float vt = vs[s * 128 + 16 * w + vi]; float o = 0.f;
#pragma unroll
            for (int j = 0; j < 8; ++j) {
                const f32x4 f4 = *(const LAS f32x4*)(fs + s * 128 + 32 * dq + 4 * j), k4 = *(const LAS f32x4*)(ks + s * 128 + 32 * dq + 4 * j), q4 = *(const LAS f32x4*)(qs + s * 128 + 32 * dq + 4 * j);
#pragma unroll
                for (int e = 0; e < 4; ++e) { S[4 * j + e] = f4[e] * S[4 * j + e] + k4[e] * vt; o += q4[e] * S[4 * j + e]; }
            }
            o += __shfl_xor(o, 16); o += __shfl_xor(o, 32);
            if (dq == 0) os[s * 128 + 16 * w + vi] = o;
        }
        __syncthreads();
        { const f32x4 o4 = *(const LAS f32x4*)(os + tt * 128 + c4); float ss = (o4.x * o4.x + o4.y * o4.y) + (o4.z * o4.z + o4.w * o4.w);
#pragma unroll
          for (int x = 1; x < 32; x <<= 1) ss += __shfl_xor(ss, x);
          const float rstd = 1.f / sqrtf(ss * (1.f / 128.f) + EPS);
          const f32x4 g4 = *(const f32x4*)(hnw + h * 128 + c4); const uint2 sw = *(const uint2*)(SG + off);
          uint2 ow; ow.x = pk2(o4.x * rstd * g4.x * bf_lo(sw.x), o4.y * rstd * g4.y * bf_hi(sw.x)); ow.y = pk2(o4.z * rstd * g4.z * bf_lo(sw.y), o4.w * rstd * g4.w * bf_hi(sw.y));
          *(uint2*)(QH + off) = ow; }
    }
}
__device__ __forceinline__ void attn_naive(unsigned char* ws, const float* sinks, int gw, int ngw, int lane) {
    bf16* AQ = (bf16*)(ws + WS_AQ); const bf16* AK = (const bf16*)(ws + WS_AK); const bf16* AV = (const bf16*)(ws + WS_AV); const bf16* AG = (const bf16*)(ws + WS_AG);
    for (int task = gw; task < BATCH * AT_HQ * T; task += ngw) {
        const int t = task & (T - 1), bh = task >> 13, head = bh & 15, b = bh >> 4, kvh = head >> 2;
        const size_t row = (size_t)b * T + t;
        float q[64];
        { const v4u* qp = (const v4u*)(AQ + row * 1024 + head * 64);
#pragma unroll
          for (int i = 0; i < 8; ++i) { const v4u x = qp[i]; q[8 * i] = bf_lo(x.x); q[8 * i + 1] = bf_hi(x.x); q[8 * i + 2] = bf_lo(x.y); q[8 * i + 3] = bf_hi(x.y); q[8 * i + 4] = bf_lo(x.z); q[8 * i + 5] = bf_hi(x.z); q[8 * i + 6] = bf_lo(x.w); q[8 * i + 7] = bf_hi(x.w); } }
        float s0 = -INFINITY, s1 = -INFINITY;
#pragma unroll
        for (int jj = 0; jj < 2; ++jj) { const int pos = t - 127 + lane + 64 * jj;
            if (pos >= 0) { const v4u* kp = (const v4u*)(AK + ((size_t)b * T + pos) * 256 + kvh * 64); float a = 0.f;
#pragma unroll
                for (int i = 0; i < 8; ++i) { const v4u x = kp[i];
                    a += q[8 * i] * bf_lo(x.x) + q[8 * i + 1] * bf_hi(x.x) + q[8 * i + 2] * bf_lo(x.y) + q[8 * i + 3] * bf_hi(x.y) + q[8 * i + 4] * bf_lo(x.z) + q[8 * i + 5] * bf_hi(x.z) + q[8 * i + 6] * bf_lo(x.w) + q[8 * i + 7] * bf_hi(x.w); }
                if (jj == 0) s0 = a; else s1 = a; } }
        const float sink2 = sinks[head] * LOG2E;
        float mx = fmaxf(fmaxf(s0, s1), sink2);
#pragma unroll
        for (int x = 1; x < 64; x <<= 1) mx = fmaxf(mx, __shfl_xor(mx, x));
        const float p0 = __builtin_amdgcn_exp2f(s0 - mx), p1 = __builtin_amdgcn_exp2f(s1 - mx);
        const float den = wave_sum(p0 + p1) + __builtin_amdgcn_exp2f(sink2 - mx);
        float o = 0.f;
#pragma unroll 8
        for (int j = 0; j < 128; ++j) { const int pos = t - 127 + j; const float pj = __shfl(j < 64 ? p0 : p1, j & 63);
            if (pos >= 0) o += pj * bf2f(AV[((size_t)b * T + pos) * 256 + kvh * 64 + lane]); }
        const float g = bf2f(AG[row * 1024 + head * 64 + lane]);
        AQ[row * 1024 + head * 64 + lane] = (bf16)f2bf(o / den * g);
    }
}

struct Args { const float* in[10]; float* out; unsigned char* ws; int ph_lo, ph_hi; };
constexpr int N_PHASES = 8;
__global__ void __launch_bounds__(NWAVES * 64, 2) fwd_kernel(Args args) {
    extern __shared__ __attribute__((aligned(16))) unsigned char lds[];
    Frame F;
    F.lds = (LAS unsigned char*)lds;
    F.MISC = (volatile LAS unsigned*)(F.lds + MISC_OFF);
    F.tid = threadIdx.x; F.lane = F.tid & 63; F.wave = __builtin_amdgcn_readfirstlane(F.tid >> 6);
    F.G = gridDim.x; { const int bx = blockIdx.x; F.vcu = (F.G % 8 == 0) ? (bx % 8) * (F.G / 8) + bx / 8 : bx; }
    unsigned char* ws = args.ws;
    F.ctl = (gu32*)(ws + WS_CTL);
    const float* x = args.in[0]; const float* norm_w = args.in[1]; const float* w_in = args.in[2]; const float* hlb = args.in[3]; const float* hnw = args.in[4];
    const float* w_bh = args.in[5]; const float* sinks = args.in[6]; const float* w_ba = args.in[7]; const float* w_out = args.in[8]; const float* fnw = args.in[9];
    float* out = args.out;
    bf16* XN = (bf16*)out;
    bf16* WinT = (bf16*)(ws + WS_WIN); bf16* WbhT = (bf16*)(ws + WS_WBH); bf16* WbaT = (bf16*)(ws + WS_WBA); bf16* WoutT = (bf16*)(ws + WS_WOUT);
    float* lbv = (float*)(ws + WS_MISC);
    for (int u = F.tid; u < (LDS_BYTES - LDSCTL_OFF) / 4; u += NWAVES * 64) ((LAS unsigned*)(F.lds + LDSCTL_OFF))[u] = 0u;
    __syncthreads();
    XcdBarrier bar = xcd_barrier_post((unsigned*)(F.ctl + CW_BAR), F.MISC + 8);
    const int lo = args.ph_lo, hi = args.ph_hi;
#define IN(k) (lo <= (k) && (k) < hi)
#define BOTH(k) (IN(k) && IN((k) + 1))
    const int gw = F.vcu * NWAVES + F.wave, NGW = F.G * NWAVES;

    if (IN(0)) {
        LAS float* scr = (LAS float*)(F.lds + RING_OFF + F.wave * 16384);
        constexpr int I_IN = (D / 64) * (DIN / 32), I_SQ = (D / 64) * (D / 32), NITEMS = I_IN + 3 * I_SQ;
        for (int it = gw; it < NITEMS; it += NGW) {
            int r = it;
            if (r < I_IN) { p0_transpose_item(w_in, D, DIN, WinT, 0, scr, r, F.lane); continue; } r -= I_IN;
            if (r < I_SQ) { p0_transpose_item(w_bh, D, D, WbhT, 0, scr, r, F.lane); continue; } r -= I_SQ;
            if (r < I_SQ) { p0_transpose_item(w_ba, D, D, WbaT, 0, scr, r, F.lane); continue; } r -= I_SQ;
            p0_transpose_item(w_out, D, D, WoutT, 0, scr, r, F.lane);
        }
        for (int m = gw; m < M; m += NGW) rms_row_to_bf16(F.lane, x + (size_t)m * D, norm_w, XN + (size_t)m * D);
        if (blockIdx.x == 0) for (int i = F.tid; i < 1024; i += NWAVES * 64) lbv[i] = 1.f / (1.f + __expf(hlb[1024 + i] - hlb[i]));
        if (BOTH(0)) xcd_barrier(bar);
    }
    if (IN(1)) {
        pg8::Gemm g{XN, WinT, M, NT_A * 256, D}; pg8::StaticOrder S; S.init(M, NT_A * 256, F.G, (int)blockIdx.x);
        pg8::EpiProj E{ws, lbv, 0};
        pg8::gemm_phase<pg8::EpiProj, pg8::StaticOrder, true, true>(F.lds + RING_OFF, g, S, E);
        if (BOTH(1)) xcd_barrier(bar);
    }
    if (IN(2)) {
        if (F.vcu < 16) hgrn_naive(F, ws, hnw, F.vcu);
        else attn_naive(ws, sinks, (F.vcu - 16) * NWAVES + F.wave, (F.G - 16) * NWAVES, F.lane);
        if (BOTH(2)) xcd_barrier(bar);
    }
    if (IN(3)) {
        pg8::Gemm g{XN, WinT + (size_t)NT_A * 256 * D, M, NT_B * 256, D}; pg8::StaticOrder S; S.init(M, NT_B * 256, F.G, (int)blockIdx.x);
        pg8::EpiProj E{ws, lbv, NT_A};
        pg8::gemm_phase<pg8::EpiProj, pg8::StaticOrder, true, true>(F.lds + RING_OFF, g, S, E);
        if (BOTH(3)) xcd_barrier(bar);
    }
    if (IN(4)) {
        { pg8::Gemm g{(const bf16*)(ws + WS_QH), WbhT, M, D, D}; pg8::StaticOrder S; S.init(M, D, F.G, (int)blockIdx.x);
          pg8::EpiBf16<0> E{(bf16*)(ws + WS_YH), D, nullptr, 0, 0, 1.f};
          pg8::gemm_phase<pg8::EpiBf16<0>, pg8::StaticOrder, true, true>(F.lds + RING_OFF, g, S, E); }
        { pg8::Gemm g{(const bf16*)(ws + WS_AQ), WbaT, M, D, D}; pg8::StaticOrder S; S.init(M, D, F.G, (int)blockIdx.x);
          pg8::EpiBf16<0> E{(bf16*)(ws + WS_YA), D, nullptr, 0, 0, 1.f};
          pg8::gemm_phase<pg8::EpiBf16<0>, pg8::StaticOrder, true, true>(F.lds + RING_OFF, g, S, E); }
        if (BOTH(4)) xcd_barrier(bar);
    }
    if (IN(5)) {
        const v4u* MH = (const v4u*)(ws + WS_MH); const v4u* MA = (const v4u*)(ws + WS_MA); const v4u* YH = (const v4u*)(ws + WS_YH); const v4u* YA = (const v4u*)(ws + WS_YA); v4u* MG = (v4u*)(ws + WS_MERGED);
        for (size_t i = (size_t)F.vcu * (NWAVES * 64) + F.tid; i < (size_t)M * D / 8; i += (size_t)F.G * NWAVES * 64) {
            const v4u a = MH[i], b = MA[i], c = YH[i], d = YA[i]; v4u o;
            o.x = pk2(bf_lo(a.x) * bf_lo(c.x) + bf_lo(b.x) * bf_lo(d.x), bf_hi(a.x) * bf_hi(c.x) + bf_hi(b.x) * bf_hi(d.x));
            o.y = pk2(bf_lo(a.y) * bf_lo(c.y) + bf_lo(b.y) * bf_lo(d.y), bf_hi(a.y) * bf_hi(c.y) + bf_hi(b.y) * bf_hi(d.y));
            o.z = pk2(bf_lo(a.z) * bf_lo(c.z) + bf_lo(b.z) * bf_lo(d.z), bf_hi(a.z) * bf_hi(c.z) + bf_hi(b.z) * bf_hi(d.z));
            o.w = pk2(bf_lo(a.w) * bf_lo(c.w) + bf_lo(b.w) * bf_lo(d.w), bf_hi(a.w) * bf_hi(c.w) + bf_hi(b.w) * bf_hi(d.w));
            MG[i] = o; }
        if (BOTH(5)) xcd_barrier(bar);
    }
    if (IN(6)) {
        pg8::Gemm g{(const bf16*)(ws + WS_MERGED), WoutT, M, D, D}; pg8::StaticOrder S; S.init(M, D, F.G, (int)blockIdx.x);
        pg8::EpiResF32 E{x, out, D};
        pg8::gemm_phase<pg8::EpiResF32, pg8::StaticOrder, true, true>(F.lds + RING_OFF, g, S, E);
        if (BOTH(6)) xcd_barrier(bar);
    }
    if (IN(7)) {
        for (int m = gw; m < M; m += NGW) rms_row_f32(F.lane, out + (size_t)m * D, fnw, out + (size_t)m * D);
    }
#undef IN
#undef BOTH
}

extern "C" void kernel_launch(void* const* d_in, const int* in_sizes, int n_in, void* d_out, int out_size, void* d_ws, size_t ws_size, hipStream_t stream) {
    static int grid = 0;
    if (grid == 0) {
        if (n_in != 10 || in_sizes[0] != M * D || out_size != M * D || ws_size < WS_END) { fprintf(stderr, "kernel_launch: unexpected shapes (n_in %d in0 %d out %d ws %zu)\n", n_in, n_in > 0 ? in_sizes[0] : -1, out_size, ws_size); grid = -1; return; }
        int dev = 0, cus = 0, per_cu = 0;
        if (hipGetDevice(&dev) != hipSuccess || hipDeviceGetAttribute(&cus, hipDeviceAttributeMultiprocessorCount, dev) != hipSuccess) { grid = -1; return; }
        if (hipFuncSetAttribute((const void*)fwd_kernel, hipFuncAttributeMaxDynamicSharedMemorySize, LDS_BYTES) != hipSuccess) { fprintf(stderr, "kernel_launch: hipFuncSetAttribute failed\n"); grid = -1; return; }
        if (hipOccupancyMaxActiveBlocksPerMultiprocessor(&per_cu, (const void*)fwd_kernel, NWAVES * 64, LDS_BYTES) != hipSuccess || per_cu < 1) { fprintf(stderr, "kernel_launch: occupancy query says %d blocks/CU\n", per_cu); }
        (void)hipGetLastError();
        grid = cus;
    }
    if (grid < 0) return;
    if (hipMemsetAsync((char*)d_ws + WS_CTL, 0, CTL_ZERO_BYTES, stream) != hipSuccess) return;
    Args a{};
    for (int i = 0; i < 10; ++i) a.in[i] = (const float*)d_in[i];
    a.out = (float*)d_out; a.ws = (unsigned char*)d_ws;
#ifndef N_LAUNCH_CUTS
    a.ph_lo = 0; a.ph_hi = N_PHASES;
    hipLaunchKernelGGL(fwd_kernel, dim3(grid), dim3(NWAVES * 64), LDS_BYTES, stream, a);
#else
    for (int p = 0; p < N_PHASES; ++p) { a.ph_lo = p; a.ph_hi = p + 1; hipLaunchKernelGGL(fwd_kernel, dim3(grid), dim3(NWAVES * 64), LDS_BYTES, stream, a); }
#endif
}
```

```cpp
#include <hip/hip_runtime.h>
#include <cstdio>
#include <cstdint>
namespace pg8 {
#define PG8_LAS __attribute__((address_space(3)))
typedef unsigned short bf16_t;
typedef short bf16x8 __attribute__((ext_vector_type(8)));
typedef float f32x4 __attribute__((ext_vector_type(4)));
typedef unsigned u32x4 __attribute__((ext_vector_type(4)));
constexpr int BM = 256, BK = 64, HALF = 128, HTB = HALF * BK * 2  , STAGE_BYTES = 8 * HTB, NXCD = 8, WGM = 8;

__host__ __device__ __forceinline__ int lds_byte(int r, int c) { const int st = (r >> 4) * 2 + (c >> 5), rr = r & 15, cc = c & 31, ob = rr * 64 + cc * 2; return st * 1024 + (ob ^ (((ob >> 9) & 1) << 5)); }
__host__ __device__ __forceinline__ void stage_rc(int b, int& R, int& C) { const int st = b / 1024, sb = b % 1024, swz = sb ^ (((sb >> 9) & 1) << 5); R = (st >> 1) * 16 + swz / 64; C = (st & 1) * 32 + (swz % 64) / 2; }
__host__ __device__ __forceinline__ int perm32(int rho) { const int n = rho >> 4, i = rho & 15; return 8 * (i >> 2) + 4 * n + (i & 3); }

struct Unit { int pm, pn; };
struct Gemm { const bf16_t* A; const bf16_t* Bt; int M, N, K; };

struct StaticOrder {
    int nM, nN, nwg, G, c;
    __host__ __device__ void init(int M, int N, int G_, int c_) { nM = M / BM; nN = N / BM; nwg = nM * nN; G = G_; c = c_; }
    __host__ __device__ bool next(int i, Unit& u) const {
        const long L = (long)i * G + c; if (L >= nwg) return false;
        int wgid = (int)L; { const int q = nwg / NXCD, r = nwg % NXCD, xcd = wgid % NXCD, off = wgid / NXCD; wgid = (xcd < r ? xcd * (q + 1) : r * (q + 1) + (xcd - r) * q) + off; }
        const int nig = WGM * nN, gid = wgid / nig, fm = gid * WGM, gsz = (nM - fm) < WGM ? (nM - fm) : WGM;
        u.pm = fm + ((wgid % nig) % gsz); u.pn = (wgid % nig) / gsz; return true;
    }
    __device__ __forceinline__ void a_ready(const Unit&) const {}
    __device__ __forceinline__ void done(const Unit&) const {}
};

typedef float f32x2c_t __attribute__((ext_vector_type(2))); typedef __bf16 bf16x2c_t __attribute__((ext_vector_type(2)));
__device__ __forceinline__ unsigned cvt_pk_bf16(float lo, float hi) { f32x2c_t v = {lo, hi}; bf16x2c_t b = __builtin_convertvector(v, bf16x2c_t); return __builtin_bit_cast(unsigned, b); }
typedef float f32x2 __attribute__((ext_vector_type(2)));
__device__ __forceinline__ f32x2 gelu_pk(f32x2 v) {
    const f32x2 av = __builtin_elementwise_abs(v), d = av * 0.2316418882f + 1.0f;
    f32x2 t; t.x = __builtin_amdgcn_rcpf(d.x); t.y = __builtin_amdgcn_rcpf(d.y);
    f32x2 q = t * 0.5307027145f + (-0.7265760135f); q = q * t + 0.7107068705f; q = q * t + (-0.142248368f); q = q * t + 0.127414796f; q = q * t;
    const f32x2 s = (v * v) * (-0.72134752044f);
    f32x2 e; e.x = __builtin_amdgcn_exp2f(s.x); e.y = __builtin_amdgcn_exp2f(s.y);
    const f32x2 m = v * (q * e), r = v - m;
    f32x2 o; o.x = v.x < 0.f ? m.x : r.x; o.y = v.y < 0.f ? m.y : r.y; return o;
}

template <int ACT  > struct EpiBf16 {
    static constexpr bool PERM = true, AFTER_DRAIN = false; static_assert(ACT == 0 || ACT == 1, "EpiBf16: ACT is 0 (none) or 1 (gelu_pk)");
    bf16_t* O; int ldc; const float* bias; int split_cols; size_t split_stride; float scale0;
    __device__ __forceinline__ void operator()(const f32x4 (&acc)[2][2][4][2], const Unit& u, int wr, int wc, int fr, int fq) const {
        const int row0 = u.pm * BM + wr * 64 + fr; int colt = u.pn * BM; bf16_t* base = O;
        float sc = 1.f; if (split_cols) { const int t = colt / split_cols; base += (size_t)t * split_stride; colt -= t * split_cols; if (t == 0) sc = scale0; }
        const int col0 = colt + wc * 32 + 8 * fq, bcol0 = u.pn * BM + wc * 32 + 8 * fq;
        f32x4 bv[2][2];
#pragma unroll
        for (int bj = 0; bj < 2; ++bj)
#pragma unroll
            for (int n = 0; n < 2; ++n) bv[bj][n] = bias ? *(const f32x4*)(bias + bcol0 + bj * HALF + 4 * n) : (f32x4){0.f, 0.f, 0.f, 0.f};
#pragma unroll
        for (int ai = 0; ai < 2; ++ai)
#pragma unroll
            for (int m = 0; m < 4; ++m) { bf16_t* rowp = base + (size_t)(row0 + ai * HALF + m * 16) * ldc + col0;
#pragma unroll
                for (int bj = 0; bj < 2; ++bj) { f32x4 v0 = acc[ai][bj][m][0] + bv[bj][0], v1 = acc[ai][bj][m][1] + bv[bj][1];
                    if (ACT == 1) { f32x2 a = gelu_pk((f32x2){v0[0], v0[1]}), b = gelu_pk((f32x2){v0[2], v0[3]}), c = gelu_pk((f32x2){v1[0], v1[1]}), d = gelu_pk((f32x2){v1[2], v1[3]});
                        v0 = (f32x4){a.x, a.y, b.x, b.y}; v1 = (f32x4){c.x, c.y, d.x, d.y}; }
                    v0 = v0 * sc; v1 = v1 * sc; u32x4 w; w.x = cvt_pk_bf16(v0[0], v0[1]); w.y = cvt_pk_bf16(v0[2], v0[3]); w.z = cvt_pk_bf16(v1[0], v1[1]); w.w = cvt_pk_bf16(v1[2], v1[3]);
                    *(u32x4*)(rowp + bj * HALF) = w; } }
    }
};

struct PanelStats {
    unsigned* xbuf;
    unsigned* cnt;
    unsigned* tmo;
    int ntn; float eps;
    unsigned code;
    __device__ __forceinline__ bool run(const f32x4 (&v)[2][2][4][2], const Unit& u, int wr, int wc, int fr, int fq, PG8_LAS unsigned char* lds, int wid, int lane) const {
        typedef float f32x2v __attribute__((ext_vector_type(2)));
        PG8_LAS f32x2v* P = (PG8_LAS f32x2v*)lds;
        PG8_LAS f32x2v* S = (PG8_LAS f32x2v*)(lds + 8192);
        PG8_LAS unsigned* flag = (PG8_LAS unsigned*)(lds + 8192 + 2048);
#pragma unroll
        for (int ai = 0; ai < 2; ++ai)
#pragma unroll
            for (int m = 0; m < 4; ++m) {
                float s = 0.f;
#pragma unroll
                for (int bj = 0; bj < 2; ++bj)
#pragma unroll
                    for (int n = 0; n < 2; ++n) { const f32x4 x = v[ai][bj][m][n]; s += (x[0] + x[1]) + (x[2] + x[3]); }
                s += __shfl_xor(s, 16); s += __shfl_xor(s, 32);
                const float mw = s * (1.0f / 64.0f); float q = 0.f;
#pragma unroll
                for (int bj = 0; bj < 2; ++bj)
#pragma unroll
                    for (int n = 0; n < 2; ++n) { const f32x4 d = v[ai][bj][m][n] - mw; q += (d[0] * d[0] + d[1] * d[1]) + (d[2] * d[2] + d[3] * d[3]); }
                q += __shfl_xor(q, 16); q += __shfl_xor(q, 32);
                if (fq == 0) P[(ai * HALF + wr * 64 + m * 16 + fr) * 4 + wc] = (f32x2v){mw, q};
            }
        asm volatile("s_waitcnt lgkmcnt(0)" ::: "memory"); __builtin_amdgcn_s_barrier(); asm volatile("" ::: "memory");
#if defined(BROKEN_EXCHANGE_NO_WAIT)
#warning BROKEN CONTROL BUILD: the row-statistics exchange does not wait; results are wrong by design
        if (blockIdx.x >= 64) { const long long t0_ = clock64(); while (clock64() - t0_ < 60000) __builtin_amdgcn_s_sleep(8); }
#endif
        const int row = wid * 32 + (lane & 31);
        if (lane < 32) {
            const f32x2v a = P[row * 4 + 0], b = P[row * 4 + 1], c = P[row * 4 + 2], d = P[row * 4 + 3];
            const float mt = (a.x + b.x + c.x + d.x) * 0.25f;
            const float da = a.x - mt, db = b.x - mt, dc = c.x - mt, dd = d.x - mt;
            const float m2 = (a.y + b.y) + (c.y + d.y) + 64.0f * ((da * da + db * db) + (dc * dc + dd * dd));
            unsigned long long* slot = (unsigned long long*)xbuf + ((size_t)(u.pm * BM + row) * 4 + u.pn);
            __hip_atomic_store(slot, ((unsigned long long)__float_as_uint(m2) << 32) | __float_as_uint(mt), __ATOMIC_RELAXED, __HIP_MEMORY_SCOPE_AGENT);
        }
        asm volatile("s_waitcnt vmcnt(0)" ::: "memory");
        if (lane == 0) __hip_atomic_fetch_add(cnt + 64 * u.pm, 1u, __ATOMIC_RELAXED, __HIP_MEMORY_SCOPE_AGENT);
        if (wid == 0) {
            bool dead = false; const unsigned long long t0 = __builtin_amdgcn_s_memrealtime(); const unsigned want = 8u * (unsigned)ntn;
            for (;;) {
#if defined(BROKEN_EXCHANGE_NO_WAIT)
                break;
#endif
                if ((unsigned)__builtin_amdgcn_readfirstlane(__hip_atomic_load(cnt + 64 * u.pm, __ATOMIC_RELAXED, __HIP_MEMORY_SCOPE_AGENT)) >= want) break;
                if (__builtin_amdgcn_s_memrealtime() - t0 > 2000000ull) {
                    if (lane == 0) { unsigned expect = 0u; __hip_atomic_compare_exchange_strong(tmo + 1, &expect, code | (unsigned)(u.pm & 0xff), __ATOMIC_RELAXED, __ATOMIC_RELAXED, __HIP_MEMORY_SCOPE_AGENT);
                                     __hip_atomic_store(tmo, 1u, __ATOMIC_RELAXED, __HIP_MEMORY_SCOPE_AGENT); }
                    dead = true; break; }
                __builtin_amdgcn_s_sleep(2);
            }
            __builtin_amdgcn_fence(__ATOMIC_ACQUIRE, "agent");
            if (lane == 0) flag[0] = dead ? 1u : 0u;
        }
        asm volatile("s_waitcnt vmcnt(0) lgkmcnt(0)" ::: "memory"); __builtin_amdgcn_s_barrier(); asm volatile("" ::: "memory");
        const bool bad = flag[0] != 0u;
        if (lane < 32) {
            const unsigned long long* slot = (const unsigned long long*)xbuf + (size_t)(u.pm * BM + row) * 4; float mt[4], m2[4]; float ms = 0.f;
#pragma unroll
            for (int t = 0; t < 4; ++t) { if (t < ntn) { const unsigned long long w = __hip_atomic_load(slot + t, __ATOMIC_RELAXED, __HIP_MEMORY_SCOPE_AGENT); mt[t] = __uint_as_float((unsigned)w); m2[t] = __uint_as_float((unsigned)(w >> 32)); } else { mt[t] = 0.f; m2[t] = 0.f; } ms += mt[t]; }
            const float mean = ms / (float)ntn; float q = 0.f;
#pragma unroll
            for (int t = 0; t < 4; ++t) if (t < ntn) { const float dm = mt[t] - mean; q += m2[t] + 256.0f * dm * dm; }
            S[row] = (f32x2v){mean, 1.0f / sqrtf(q / (256.0f * (float)ntn) + eps)};
        }
        asm volatile("s_waitcnt lgkmcnt(0)" ::: "memory"); __builtin_amdgcn_s_barrier(); asm volatile("" ::: "memory");
        return bad;
    }
};
struct EpiLnRes {
    static constexpr bool PERM = false, AFTER_DRAIN = true;
    const float* base; float* out; int ldc; const float* bias; PanelStats st; unsigned poison;
    __device__ __forceinline__ void fused(f32x4 (&acc)[2][2][4][2], const Unit& u, int wr, int wc, int fr, int fq, PG8_LAS unsigned char* lds, int wid, int lane) const {
        typedef float f32x2v __attribute__((ext_vector_type(2)));
        const PG8_LAS f32x2v* S = (const PG8_LAS f32x2v*)(lds + 8192);
        const int col0 = u.pn * BM + wc * 32 + 4 * fq;
#pragma unroll
        for (int bj = 0; bj < 2; ++bj)
#pragma unroll
            for (int n = 0; n < 2; ++n) { const f32x4 bv = bias ? *(const f32x4*)(bias + col0 + bj * HALF + n * 16) : (f32x4){0.f, 0.f, 0.f, 0.f};
#pragma unroll
                for (int ai = 0; ai < 2; ++ai)
#pragma unroll
                    for (int m = 0; m < 4; ++m) acc[ai][bj][m][n] += bv; }
        f32x4 pre[4][2][2];
#pragma unroll
        for (int m = 0; m < 4; ++m) { const size_t off = (size_t)(u.pm * BM + wr * 64 + m * 16 + fr) * ldc + col0;
#pragma unroll
            for (int bj = 0; bj < 2; ++bj)
#pragma unroll
                for (int n = 0; n < 2; ++n) pre[m][bj][n] = *(const f32x4*)(base + off + bj * HALF + n * 16); }
        const bool bad = st.run(acc, u, wr, wc, fr, fq, lds, wid, lane) || poison != 0u;
        const float qnan = __builtin_nanf("");
#pragma unroll
        for (int ai = 0; ai < 2; ++ai)
#pragma unroll
            for (int m = 0; m < 4; ++m) { const int r = ai * HALF + wr * 64 + m * 16 + fr; const f32x2v sr = S[r]; const size_t off = (size_t)(u.pm * BM + r) * ldc + col0;
#pragma unroll
                for (int bj = 0; bj < 2; ++bj)
#pragma unroll
                    for (int n = 0; n < 2; ++n) { const f32x4 bs = ai == 0 ? pre[m][bj][n] : *(const f32x4*)(base + off + bj * HALF + n * 16); f32x4 o = bs + (acc[ai][bj][m][n] - sr.x) * sr.y;
                        if (bad) o = (f32x4){qnan, qnan, qnan, qnan}; *(f32x4*)(out + off + bj * HALF + n * 16) = o; }
                if (m & 1) asm volatile("" ::: "memory"); }
    }
};
struct EpiLnResLn {
    static constexpr bool PERM = false, AFTER_DRAIN = true;
    const float* base; float* out; bf16_t* xn; int ldc; const float* bias; PanelStats st1, st2; unsigned poison;
    __device__ __forceinline__ void fused(f32x4 (&acc)[2][2][4][2], const Unit& u, int wr, int wc, int fr, int fq, PG8_LAS unsigned char* lds, int wid, int lane) const {
        typedef float f32x2v __attribute__((ext_vector_type(2))); typedef unsigned u32x2v __attribute__((ext_vector_type(2)));
        const PG8_LAS f32x2v* S = (const PG8_LAS f32x2v*)(lds + 8192);
        const int col0 = u.pn * BM + wc * 32 + 4 * fq;
#pragma unroll
        for (int bj = 0; bj < 2; ++bj)
#pragma unroll
            for (int n = 0; n < 2; ++n) { const f32x4 bv = bias ? *(const f32x4*)(bias + col0 + bj * HALF + n * 16) : (f32x4){0.f, 0.f, 0.f, 0.f};
#pragma unroll
                for (int ai = 0; ai < 2; ++ai)
#pragma unroll
                    for (int m = 0; m < 4; ++m) acc[ai][bj][m][n] += bv; }
        bool bad = st1.run(acc, u, wr, wc, fr, fq, lds, wid, lane) || poison != 0u;
        const float qnan = __builtin_nanf("");
#pragma unroll
        for (int ai = 0; ai < 2; ++ai)
#pragma unroll
            for (int m = 0; m < 4; ++m) { const int r = ai * HALF + wr * 64 + m * 16 + fr; const f32x2v sr = S[r]; const size_t off = (size_t)(u.pm * BM + r) * ldc + col0;
#pragma unroll
                for (int bj = 0; bj < 2; ++bj)
#pragma unroll
                    for (int n = 0; n < 2; ++n) { const f32x4 bs = *(const f32x4*)(base + off + bj * HALF + n * 16); acc[ai][bj][m][n] = bs + (acc[ai][bj][m][n] - sr.x) * sr.y; }
                asm volatile("" : "+v"(acc[ai][0][m][0]), "+v"(acc[ai][0][m][1]), "+v"(acc[ai][1][m][0]), "+v"(acc[ai][1][m][1]));
                if (m & 1) asm volatile("" ::: "memory"); }
        const bool bad1 = bad;
        bad = st2.run(acc, u, wr, wc, fr, fq, lds, wid, lane) || bad;
#pragma unroll
        for (int ai = 0; ai < 2; ++ai)
#pragma unroll
            for (int m = 0; m < 4; ++m) { const int r = ai * HALF + wr * 64 + m * 16 + fr; const f32x2v sr = S[r]; const size_t off = (size_t)(u.pm * BM + r) * ldc + col0;
#pragma unroll
                for (int bj = 0; bj < 2; ++bj)
#pragma unroll
                    for (int n = 0; n < 2; ++n) { const f32x4 x1 = acc[ai][bj][m][n]; *(f32x4*)(out + off + bj * HALF + n * 16) = bad1 ? (f32x4){qnan, qnan, qnan, qnan} : x1;
                        const f32x4 o = (x1 - sr.x) * sr.y; u32x2v w; w.x = cvt_pk_bf16(o[0], o[1]); w.y = cvt_pk_bf16(o[2], o[3]);
                        if (bad) { w.x = 0x7fc07fc0u; w.y = 0x7fc07fc0u; } *(u32x2v*)(xn + off + bj * HALF + n * 16) = w; }
                asm volatile("" ::: "memory"); }
    }
};

template <class Epi, class Sched, bool ALIGN_EPI = false, bool SP2 = false>
__device__ __forceinline__ void gemm_phase(PG8_LAS unsigned char* lds, const Gemm g, const Sched& S, const Epi& E) {
    const int tid = threadIdx.x, wid = __builtin_amdgcn_readfirstlane(tid >> 6), lane = tid & 63, wr = wid >> 2, wc = wid & 3, fr = lane & 15, fq = lane >> 4;
    const int K = g.K, nt = K / BK;
    unsigned voffA[2], voffB[2];
#pragma unroll
    for (int i = 0; i < 2; ++i) { int R, C; stage_rc(tid * 16 + i * 8192, R, C); const int Rb = Epi::PERM ? ((R & ~31) + perm32(R & 31)) : R;
        voffA[i] = (unsigned)(R * K + C) * 2u; voffB[i] = (unsigned)(Rb * K + C) * 2u; }
    const size_t kstep = (size_t)(BK * 2);
    const size_t hstep = (size_t)HALF * K * 2;
    const size_t tstep = 2 * hstep;
    const unsigned ldsw = (unsigned)wid * 1024u;
    const int aoff = lds_byte(wr * 64 + fr, fq * 8), boff = lds_byte(wc * 32 + fr, fq * 8);
#define PG8_SA(b, h) (((b) * 2 + (h)) * HTB)
#define PG8_SB(b, h) ((4 + (b) * 2 + (h)) * HTB)
#define PG8_STAGE(bufoff, gbase, voff) do { _Pragma("unroll") for (int _i = 0; _i < 2; ++_i) \
        __builtin_amdgcn_global_load_lds((const unsigned*)((const char*)(gbase) + (voff)[_i]), (PG8_LAS unsigned*)(lds + (bufoff) + ldsw + _i * 8192), 16, 0, 0); } while (0)
#define PG8_LDA(dst, b, h) do { _Pragma("unroll") for (int m = 0; m < 4; ++m) _Pragma("unroll") for (int k = 0; k < 2; ++k) dst[m][k] = *(const PG8_LAS bf16x8*)(lds + PG8_SA(b, h) + aoff + m * 2048 + k * 1024); } while (0)
#define PG8_LDB(dst, b, h) do { _Pragma("unroll") for (int n = 0; n < 2; ++n) _Pragma("unroll") for (int k = 0; k < 2; ++k) dst[n][k] = *(const PG8_LAS bf16x8*)(lds + PG8_SB(b, h) + boff + n * 2048 + k * 1024); } while (0)
#define PG8_MMA(ai, bj, At, Bt) do { __builtin_amdgcn_s_setprio(1); _Pragma("unroll") for (int m = 0; m < 4; ++m) _Pragma("unroll") for (int n = 0; n < 2; ++n) _Pragma("unroll") for (int k = 0; k < 2; ++k) \
        acc[ai][bj][m][n] = __builtin_amdgcn_mfma_f32_16x16x32_bf16(Bt[n][k], At[m][k], acc[ai][bj][m][n], 0, 0, 0); __builtin_amdgcn_s_setprio(0); } while (0)
#define PG8_WAIT_V(n) asm volatile("s_waitcnt vmcnt(" #n ")" ::: "memory")
#define PG8_WAIT_L(n) asm volatile("s_waitcnt lgkmcnt(" #n ")" ::: "memory")
#define PG8_BAR __builtin_amdgcn_s_barrier()
#define PG8_SCHED __builtin_amdgcn_sched_barrier(0)
    Unit cur, nxt; int ui = 0;
    if (!S.next(0, cur)) return;
    f32x4 acc[2][2][4][2];
#pragma unroll
    for (int a = 0; a < 2; ++a)
#pragma unroll
        for (int b = 0; b < 2; ++b)
#pragma unroll
            for (int m = 0; m < 4; ++m)
#pragma unroll
                for (int n = 0; n < 2; ++n) acc[a][b][m][n] = (f32x4){0.f, 0.f, 0.f, 0.f};
    bf16x8 At[4][2], B0[2][2], B1[2][2];
    const char* cA = (const char*)g.A + (size_t)cur.pm * tstep; const char* cB = (const char*)g.Bt + (size_t)cur.pn * tstep;
    S.a_ready(cur);
    if constexpr (SP2) {
        PG8_STAGE(PG8_SB(0, 0), cB, voffB); PG8_STAGE(PG8_SB(0, 1), cB + hstep, voffB); PG8_STAGE(PG8_SA(0, 0), cA, voffA); PG8_STAGE(PG8_SA(0, 1), cA + hstep, voffA);
        if (wr == 1) PG8_BAR;
        PG8_WAIT_V(2); PG8_BAR;
        PG8_STAGE(PG8_SB(1, 0), cB + kstep, voffB); PG8_STAGE(PG8_SA(1, 0), cA + kstep, voffA); PG8_STAGE(PG8_SB(1, 1), cB + hstep + kstep, voffB);
        PG8_WAIT_V(6); PG8_BAR;
    } else {
        PG8_STAGE(PG8_SB(0, 0), cB, voffB); PG8_STAGE(PG8_SA(0, 0), cA, voffA); PG8_STAGE(PG8_SB(0, 1), cB + hstep, voffB); PG8_STAGE(PG8_SA(0, 1), cA + hstep, voffA);
        if (wr == 1) PG8_BAR;
        PG8_WAIT_V(4); PG8_BAR;
        PG8_STAGE(PG8_SB(1, 0), cB + kstep, voffB); PG8_STAGE(PG8_SA(1, 0), cA + kstep, voffA); PG8_STAGE(PG8_SB(1, 1), cB + hstep + kstep, voffB);
        PG8_WAIT_V(6); PG8_BAR;
    }
    for (;;) {
        const bool has_next = S.next(ui + 1, nxt);
        const char* nA = has_next ? (const char*)g.A + (size_t)nxt.pm * tstep : cA; const char* nB = has_next ? (const char*)g.Bt + (size_t)nxt.pn * tstep : cB;
        for (int t = 0; t < nt; t += 2) {
            const bool last = (t == nt - 2);
            const char* a1 = cA + (size_t)(t + 1) * kstep;
            const char* a2 = last ? nA : cA + (size_t)(t + 2) * kstep; const char* b2 = last ? nB : cB + (size_t)(t + 2) * kstep;
            const char* a3 = a2 + kstep; const char* b3 = b2 + kstep;
            if (last && has_next) S.a_ready(nxt);
            if constexpr (SP2) {
            PG8_LDB(B0, 0, 0); PG8_LDB(B1, 0, 1); PG8_SCHED; PG8_LDA(At, 0, 0); PG8_STAGE(PG8_SA(1, 1), a1 + hstep, voffA);
            PG8_WAIT_V(8); PG8_WAIT_L(0); PG8_BAR; PG8_MMA(0, 0, At, B0); PG8_MMA(0, 1, At, B1); PG8_BAR; PG8_SCHED;
            PG8_LDA(At, 0, 1); PG8_STAGE(PG8_SB(0, 0), b2, voffB); PG8_STAGE(PG8_SB(0, 1), b2 + hstep, voffB); PG8_STAGE(PG8_SA(0, 0), a2, voffA);
            PG8_WAIT_V(8); PG8_WAIT_L(0); PG8_BAR; PG8_MMA(1, 0, At, B0); PG8_MMA(1, 1, At, B1); PG8_BAR; PG8_SCHED;
            PG8_LDB(B0, 1, 0); PG8_LDB(B1, 1, 1); PG8_SCHED; PG8_LDA(At, 1, 0); PG8_STAGE(PG8_SA(0, 1), a2 + hstep, voffA);
            PG8_WAIT_V(8); PG8_WAIT_L(0); PG8_BAR; PG8_MMA(0, 0, At, B0); PG8_MMA(0, 1, At, B1); PG8_BAR; PG8_SCHED;
            PG8_LDA(At, 1, 1); PG8_STAGE(PG8_SB(1, 0), b3, voffB); PG8_STAGE(PG8_SB(1, 1), b3 + hstep, voffB); PG8_STAGE(PG8_SA(1, 0), a3, voffA);
            PG8_WAIT_V(8); PG8_WAIT_L(0); PG8_BAR; PG8_MMA(1, 0, At, B0); PG8_MMA(1, 1, At, B1); PG8_BAR; PG8_SCHED;
            } else {
            PG8_LDB(B0, 0, 0); PG8_SCHED; PG8_LDA(At, 0, 0); PG8_STAGE(PG8_SA(1, 1), a1 + hstep, voffA);
            PG8_WAIT_L(8); PG8_BAR; PG8_WAIT_L(0); PG8_MMA(0, 0, At, B0); PG8_BAR; PG8_SCHED;
            PG8_LDB(B1, 0, 1); PG8_STAGE(PG8_SB(0, 0), b2, voffB);
            PG8_BAR; PG8_WAIT_L(0); PG8_MMA(0, 1, At, B1); PG8_BAR;
            PG8_LDA(At, 0, 1); PG8_STAGE(PG8_SA(0, 0), a2, voffA);
            PG8_BAR; PG8_WAIT_L(0); PG8_MMA(1, 0, At, B0); PG8_BAR; PG8_SCHED;
            PG8_STAGE(PG8_SB(0, 1), b2 + hstep, voffB);
            PG8_WAIT_V(6); PG8_BAR; PG8_MMA(1, 1, At, B1); PG8_BAR;
            PG8_LDB(B0, 1, 0); PG8_SCHED; PG8_LDA(At, 1, 0); PG8_STAGE(PG8_SA(0, 1), a2 + hstep, voffA);
            PG8_WAIT_L(8); PG8_BAR; PG8_WAIT_L(0); PG8_MMA(0, 0, At, B0); PG8_BAR; PG8_SCHED;
            PG8_LDB(B1, 1, 1); PG8_STAGE(PG8_SB(1, 0), b3, voffB);
            PG8_BAR; PG8_WAIT_L(0); PG8_MMA(0, 1, At, B1); PG8_BAR;
            PG8_LDA(At, 1, 1); PG8_STAGE(PG8_SA(1, 0), a3, voffA);
            PG8_BAR; PG8_WAIT_L(0); PG8_MMA(1, 0, At, B0); PG8_BAR; PG8_SCHED;
            PG8_STAGE(PG8_SB(1, 1), b3 + hstep, voffB);
            PG8_WAIT_V(6); PG8_BAR; PG8_MMA(1, 1, At, B1); PG8_BAR;
            }
        }
        if constexpr (ALIGN_EPI) { if (wr == 0) PG8_BAR; }
        if constexpr (!Epi::AFTER_DRAIN) { E(acc, cur, wr, wc, fr, fq); S.done(cur); }
        if (!has_next) break;
#pragma unroll
        for (int a = 0; a < 2; ++a)
#pragma unroll
            for (int b = 0; b < 2; ++b)
#pragma unroll
                for (int m = 0; m < 4; ++m)
#pragma unroll
                    for (int n = 0; n < 2; ++n) acc[a][b][m][n] = (f32x4){0.f, 0.f, 0.f, 0.f};
        cur = nxt; cA = nA; cB = nB; ++ui;
        if constexpr (ALIGN_EPI) { if (wr == 1) PG8_BAR; }
    }
    PG8_WAIT_V(0);
    if constexpr (!ALIGN_EPI) { if (wr == 0) PG8_BAR; }
    PG8_BAR;
    if constexpr (Epi::AFTER_DRAIN) { E.fused(acc, cur, wr, wc, fr, fq, lds, wid, lane); S.done(cur); }
#undef PG8_SA
#undef PG8_SB
#undef PG8_STAGE
#undef PG8_LDA
#undef PG8_LDB
#undef PG8_MMA
#undef PG8_WAIT_V
#undef PG8_WAIT_L
#undef PG8_BAR
#undef PG8_SCHED
}
}

#ifndef PG8_SP2
#define PG8_SP2 true
#endif
#ifndef PG8_ALIGN
#define PG8_ALIGN true
#endif
constexpr int NWAVES = 8;
constexpr int BATCH = 2, T = 8192, D = 1024, M = BATCH * T, DIN = 8704;
constexpr int HG_H = 8, AT_HQ = 16;
constexpr float EPS = 1e-6f;
constexpr float LOG2E = 1.4426950408889634f;
constexpr float C2 = 0.125f * LOG2E;
constexpr int NT_A = 26, NT_B = 8;
constexpr size_t MiB = 1u << 20;
constexpr size_t WS_CTL = 0, CTL_ZERO_BYTES = 1 * MiB;
constexpr size_t WS_WBH = 1 * MiB, WS_WBA = 3 * MiB, WS_WOUT = 5 * MiB, WS_WIN = 7 * MiB;
constexpr size_t WS_QH = 24 * MiB, WS_GH = 56 * MiB, WS_VH = 88 * MiB, WS_SG = 120 * MiB, WS_AQ = 152 * MiB, WS_AK = 184 * MiB, WS_AV = 192 * MiB, WS_AG = 200 * MiB, WS_MISC = 232 * MiB, WS_END = 256 * MiB;
constexpr size_t WS_MH = WS_GH, WS_MA = WS_VH, WS_YH = WS_SG, WS_YA = WS_AG, WS_MERGED = WS_QH;
constexpr int CW_TMO = 0, CW_CODE = 1, CW_BAR = 4096;
constexpr int RING_OFF = 0, RING_BYTES = 131072;
constexpr int LDSCTL_OFF = 143360, MISC_OFF = LDSCTL_OFF + 320;
constexpr int LDS_BYTES = 147456;
namespace pg8 {
enum { K_NONE = 0, K_SILU = 1, K_SIG = 2, K_LOGF = 3, K_SCALE = 4 };
typedef _Float16 f16x2 __attribute__((ext_vector_type(2)));
__device__ __forceinline__ float act_sigmoid(float x) { return __builtin_amdgcn_rcpf(1.f + __builtin_amdgcn_exp2f(-1.4426950408889634f * x)); }
template <int KIND> __device__ __forceinline__ unsigned act_pk(float a, float b, float la, float lb) {
    if (KIND == K_NONE) return cvt_pk_bf16(a, b);
    if (KIND == K_SCALE) return cvt_pk_bf16(a * (0.125f * 1.4426950408889634f), b * (0.125f * 1.4426950408889634f));
    if (KIND == K_SILU) return cvt_pk_bf16(a * act_sigmoid(a), b * act_sigmoid(b));
    if (KIND == K_SIG) return cvt_pk_bf16(act_sigmoid(a), act_sigmoid(b));
    const float fa = la + (1.f - la) * act_sigmoid(a), fb = lb + (1.f - lb) * act_sigmoid(b);
    f16x2 h; h.x = (_Float16)__builtin_amdgcn_logf(fa); h.y = (_Float16)__builtin_amdgcn_logf(fb); return __builtin_bit_cast(unsigned, h);
}
struct EpiProj {
    static constexpr bool PERM = true, AFTER_DRAIN = false;
    unsigned char* ws; const float* lb; int pn0;
    template <int KIND> __device__ __forceinline__ void tile(const f32x4 (&acc)[2][2][4][2], bf16_t* base, int ld, int row0, int col0) const {
#pragma unroll
        for (int bj = 0; bj < 2; ++bj) {
            f32x4 l0 = (f32x4){0.f, 0.f, 0.f, 0.f}, l1 = l0;
            if (KIND == K_LOGF) { l0 = *(const f32x4*)(lb + col0 + bj * HALF); l1 = *(const f32x4*)(lb + col0 + bj * HALF + 4); }
#pragma unroll
            for (int ai = 0; ai < 2; ++ai)
#pragma unroll
                for (int m = 0; m < 4; ++m) {
                    const f32x4 v0 = acc[ai][bj][m][0], v1 = acc[ai][bj][m][1];
                    u32x4 w; w.x = act_pk<KIND>(v0[0], v0[1], l0[0], l0[1]); w.y = act_pk<KIND>(v0[2], v0[3], l0[2], l0[3]);
                    w.z = act_pk<KIND>(v1[0], v1[1], l1[0], l1[1]); w.w = act_pk<KIND>(v1[2], v1[3], l1[2], l1[3]);
                    *(u32x4*)(base + (size_t)(row0 + ai * HALF + m * 16) * ld + col0 + bj * HALF) = w;
                }
        }
    }
    __device__ __forceinline__ void operator()(const f32x4 (&acc)[2][2][4][2], const Unit& u, int wr, int wc, int fr, int fq) const {
        const int ct = u.pn + pn0, row0 = u.pm * BM + wr * 64 + fr, cl = wc * 32 + 8 * fq;
        if (ct < 4)        tile<K_SILU>(acc, (bf16_t*)(ws + WS_QH), 1024, row0, ct * 256 + cl);
        else if (ct < 8)   tile<K_LOGF>(acc, (bf16_t*)(ws + WS_GH), 1024, row0, (ct - 4) * 256 + cl);
        else if (ct < 12)  tile<K_NONE>(acc, (bf16_t*)(ws + WS_VH), 1024, row0, (ct - 8) * 256 + cl);
        else if (ct < 16)  tile<K_SILU>(acc, (bf16_t*)(ws + WS_SG), 1024, row0, (ct - 12) * 256 + cl);
        else if (ct < 20)  tile<K_SCALE>(acc, (bf16_t*)(ws + WS_AQ), 1024, row0, (ct - 16) * 256 + cl);
        else if (ct == 20) tile<K_NONE>(acc, (bf16_t*)(ws + WS_AK), 256, row0, cl);
        else if (ct == 21) tile<K_NONE>(acc, (bf16_t*)(ws + WS_AV), 256, row0, cl);
        else if (ct < 26)  tile<K_SILU>(acc, (bf16_t*)(ws + WS_AG), 1024, row0, (ct - 22) * 256 + cl);
        else if (ct < 30)  tile<K_SIG>(acc, (bf16_t*)(ws + WS_MH), 1024, row0, (ct - 26) * 256 + cl);
        else               tile<K_SIG>(acc, (bf16_t*)(ws + WS_MA), 1024, row0, (ct - 30) * 256 + cl);
    }
};
struct EpiResF32 {
    static constexpr bool PERM = false, AFTER_DRAIN = false;
    const float* base; float* out; int ldc;
    __device__ __forceinline__ void operator()(const f32x4 (&acc)[2][2][4][2], const Unit& u, int wr, int wc, int fr, int fq) const {
        const int row0 = u.pm * BM + wr * 64 + fr, col0 = u.pn * BM + wc * 32 + 4 * fq;
#pragma unroll
        for (int ai = 0; ai < 2; ++ai)
#pragma unroll
            for (int m = 0; m < 4; ++m) { const size_t off = (size_t)(row0 + ai * HALF + m * 16) * ldc + col0;
#pragma unroll
                for (int bj = 0; bj < 2; ++bj)
#pragma unroll
                    for (int n = 0; n < 2; ++n) { const f32x4 bs = *(const f32x4*)(base + off + bj * HALF + n * 16); *(f32x4*)(out + off + bj * HALF + n * 16) = bs + acc[ai][bj][m][n]; } }
    }
};
}
#define GAS __attribute__((address_space(1)))
#define LAS __attribute__((address_space(3)))
typedef unsigned short bf16;
typedef unsigned v4u __attribute__((ext_vector_type(4)));
typedef float f32x4 __attribute__((ext_vector_type(4)));
typedef short bf16x8 __attribute__((ext_vector_type(8)));
typedef GAS unsigned gu32;
typedef GAS unsigned long long gu64;
#define RLX_AGENT __ATOMIC_RELAXED, __HIP_MEMORY_SCOPE_AGENT
#define LDS_WAIT() asm volatile("s_waitcnt lgkmcnt(0)" ::: "memory")
#define VM_WAIT() asm volatile("s_waitcnt vmcnt(0)" ::: "memory")
__device__ __forceinline__ unsigned long long rt() { return __builtin_amdgcn_s_memrealtime(); }
__device__ __forceinline__ unsigned f2bf(float f) { unsigned u = __builtin_bit_cast(unsigned, f); return (u + 0x7fffu + ((u >> 16) & 1u)) >> 16; }
__device__ __forceinline__ unsigned pk2(float lo, float hi) { return f2bf(lo) | (f2bf(hi) << 16); }

#define XB_TMO      128
#define XB_XCNT(j)  (256  + 64 * (j))
#define XB_XSUB(j)  (1280 + 64 * (j))
#define XB_XGEN(j)  (2304 + 64 * (j))
#define XB_TOP      3328
#define XB_TOPGEN   3392
#define XCD_BAR_WORDS 3456
#define XB_SPIN_CAP (1u << 18)

__device__ __forceinline__ unsigned xb_ld(unsigned* p)              { return __hip_atomic_load(p, __ATOMIC_RELAXED, __HIP_MEMORY_SCOPE_AGENT); }
__device__ __forceinline__ unsigned xb_add(unsigned* p, unsigned v) { return __hip_atomic_fetch_add(p, v, __ATOMIC_RELAXED, __HIP_MEMORY_SCOPE_AGENT); }
__device__ __forceinline__ unsigned xb_xcc_id() { return (unsigned)__builtin_amdgcn_s_getreg((3 << 11) | 20) & 0xFu; }
#define XB_SPIN(cond, bar) do { unsigned _sp = 0; while (cond) { __builtin_amdgcn_s_sleep(1); \
    if ((++_sp & 255u) == 0u) { if (xb_ld(&(bar)[XB_TMO])) break; if (_sp > XB_SPIN_CAP) { atomicAdd(&(bar)[XB_TMO], 1u); break; } } } } while (0)

struct XcdBarrier {
    unsigned* bar; unsigned x;
    volatile LAS unsigned* st;
};

__device__ __forceinline__ XcdBarrier xcd_barrier_post(unsigned* bar, volatile LAS unsigned* st) {
    XcdBarrier b; b.bar = bar; b.x = xb_xcc_id(); b.st = st;
    if (threadIdx.x == 0) (void)xb_add(&bar[XB_XCNT(b.x)], 1u);
    return b;
}
__device__ __forceinline__ void xcd_barrier_complete(unsigned* bar, unsigned x, unsigned& nloc, unsigned& nx) {
    const unsigned G = gridDim.x * gridDim.y * gridDim.z;
    unsigned sum, cnt, mine, sp = 0u;
    for (;;) {
        sum = 0u; cnt = 0u; mine = 0u;
#pragma unroll
        for (unsigned j = 0; j < 16; ++j) { const unsigned c = xb_ld(&bar[XB_XCNT(j)]); sum += c; cnt += (c > 0u) ? 1u : 0u; mine = (j == x) ? c : mine; }
        if (sum == G) break;
        __builtin_amdgcn_s_sleep(1);
        if ((++sp & 255u) == 0u) { if (xb_ld(&bar[XB_TMO])) break; if (sp > XB_SPIN_CAP) { atomicAdd(&bar[XB_TMO], 1u); break; } }
    }
    nloc = mine > 0u ? mine : 1u; nx = cnt > 0u ? cnt : 1u;
}

__device__ __forceinline__ void xcd_barrier(const XcdBarrier& b) {
    asm volatile("s_waitcnt vmcnt(0)" ::: "memory");
    __syncthreads();
    if (threadIdx.x == 0) {
        unsigned* bar = b.bar;
        __builtin_amdgcn_s_waitcnt(0);
        unsigned nloc = b.st[0], nx = b.st[1];
        if (nloc == 0u) { xcd_barrier_complete(bar, b.x, nloc, nx); b.st[0] = nloc; b.st[1] = nx; }
        const unsigned old = xb_add(&bar[XB_XSUB(b.x)], 1u);
        const unsigned gen = old / nloc;
        if (old + 1u == (gen + 1u) * nloc) {
            __builtin_amdgcn_fence(__ATOMIC_RELEASE, "agent");
            asm volatile("s_waitcnt vmcnt(0)" ::: "memory");
            const unsigned og = xb_add(&bar[XB_TOP], 1u);
            const unsigned tg = og / nx;
            if (og + 1u == (tg + 1u) * nx) xb_add(&bar[XB_TOPGEN], 1u);
            else XB_SPIN(xb_ld(&bar[XB_TOPGEN]) == tg, bar);
            __builtin_amdgcn_fence(__ATOMIC_ACQUIRE, "agent");
            xb_add(&bar[XB_XGEN(b.x)], 1u);
            asm volatile("s_waitcnt vmcnt(0)" ::: "memory");
        } else {
            XB_SPIN(xb_ld(&bar[XB_XGEN(b.x)]) == gen, bar);
            __builtin_amdgcn_fence(__ATOMIC_ACQUIRE, "agent");
            asm volatile("s_waitcnt vmcnt(0)" ::: "memory");
        }
    }
    __syncthreads();
}
__device__ __forceinline__ float wave_sum(float v) {
#pragma unroll
    for (int o = 1; o < 64; o <<= 1) v += __shfl_xor(v, o);
    return v;
}
__device__ __forceinline__ void p0_transpose_item(const float* W, int K, int N, bf16* WT, int row_off, LAS float* scr, int item, int lane) {
    const int nblk = N / 32, kb = item / nblk, nb = item % nblk, k0 = 64 * kb, n0 = 32 * nb;
#pragma unroll 8
    for (int i = 0; i < 32; ++i) { const int kk = 2 * i + (lane >> 5); scr[kk * 33 + (lane & 31)] = W[(size_t)(k0 + kk) * N + n0 + (lane & 31)]; }
    LDS_WAIT(); asm volatile("" ::: "memory");
    const int c = lane & 7;
#pragma unroll
    for (int j = 0; j < 4; ++j) { const int n = (lane >> 3) + 8 * j; const LAS float* s = scr + (8 * c) * 33 + n;
        v4u o; o.x = pk2(s[0 * 33], s[1 * 33]); o.y = pk2(s[2 * 33], s[3 * 33]); o.z = pk2(s[4 * 33], s[5 * 33]); o.w = pk2(s[6 * 33], s[7 * 33]);
        *(GAS v4u*)(WT + (size_t)(row_off + n0 + n) * K + k0 + 8 * c) = o; }
    LDS_WAIT(); asm volatile("" ::: "memory");
}
struct Frame {
    LAS unsigned char* lds;
    volatile LAS unsigned* MISC;
    gu32* ctl;
    int tid, lane, wave, vcu, G;
};
__device__ __forceinline__ float bf_lo(unsigned w) { return __uint_as_float(w << 16); }
__device__ __forceinline__ float bf_hi(unsigned w) { return __uint_as_float(w & 0xffff0000u); }
__device__ __forceinline__ float bf2f(bf16 h) { return __uint_as_float((unsigned)h << 16); }
typedef _Float16 h16x2 __attribute__((ext_vector_type(2)));
__device__ __forceinline__ float h_lo(unsigned w) { return (float)__builtin_bit_cast(h16x2, w).x; }
__device__ __forceinline__ float h_hi(unsigned w) { return (float)__builtin_bit_cast(h16x2, w).y; }

__device__ __forceinline__ void rms_row_to_bf16(int lane, const float* xrow, const float* w, bf16* orow) {
    const GAS f32x4* xr = (const GAS f32x4*)xrow + lane; const GAS f32x4* wr = (const GAS f32x4*)w + lane;
    f32x4 v[4]; float s = 0.f;
#pragma unroll
    for (int j = 0; j < 4; ++j) { v[j] = xr[64 * j]; s += (v[j].x * v[j].x + v[j].y * v[j].y) + (v[j].z * v[j].z + v[j].w * v[j].w); }
    const float rstd = 1.f / sqrtf(wave_sum(s) * (1.f / D) + EPS);
    GAS unsigned long long* o8 = (GAS unsigned long long*)orow + lane;
#pragma unroll
    for (int j = 0; j < 4; ++j) { const f32x4 g = wr[64 * j];
        o8[64 * j] = (unsigned long long)pk2(v[j].x * rstd * g.x, v[j].y * rstd * g.y) | ((unsigned long long)pk2(v[j].z * rstd * g.z, v[j].w * rstd * g.w) << 32); }
}
__device__ __forceinline__ void rms_row_f32(int lane, const float* xrow, const float* w, float* orow) {
    const GAS f32x4* xr = (const GAS f32x4*)xrow + lane; const GAS f32x4* wr = (const GAS f32x4*)w + lane;
    f32x4 v[4]; float s = 0.f;
#pragma unroll
    for (int j = 0; j < 4; ++j) { v[j] = xr[64 * j]; s += (v[j].x * v[j].x + v[j].y * v[j].y) + (v[j].z * v[j].z + v[j].w * v[j].w); }
    const float rstd = 1.f / sqrtf(wave_sum(s) * (1.f / D) + EPS);
    GAS f32x4* o = (GAS f32x4*)orow + lane;
#pragma unroll
    for (int j = 0; j < 4; ++j) { const f32x4 g = wr[64 * j]; o[64 * j] = v[j] * rstd * g; }
}

__device__ __forceinline__ void hgrn_naive(Frame& F, unsigned char* ws, const float* hnw, int bh) {
    const int b = bh >> 3, h = bh & 7, tid = F.tid, lane = F.lane, w = F.wave, vi = lane & 15, dq = lane >> 4;
    LAS float* qs = (LAS float*)(F.lds + RING_OFF); LAS float* fs = qs + 2048; LAS float* ks = fs + 2048; LAS float* vs = ks + 2048; LAS float* os = vs + 2048;
    bf16* QH = (bf16*)(ws + WS_QH); const bf16* GH = (const bf16*)(ws + WS_GH); const bf16* VH = (const bf16*)(ws + WS_VH); const bf16* SG = (const bf16*)(ws + WS_SG);
    float S[32];
#pragma unroll
    for (int i = 0; i < 32; ++i) S[i] = 0.f;
    const int tt = tid >> 5, c4 = (tid & 31) * 4;
    for (int t0 = 0; t0 < T; t0 += 16) {
        const size_t off = ((size_t)b * T + t0 + tt) * 1024 + h * 128 + c4;
        { const uint2 qw = *(const uint2*)(QH + off), gw = *(const uint2*)(GH + off), vw = *(const uint2*)(VH + off);
          const f32x4 q4 = {bf_lo(qw.x), bf_hi(qw.x), bf_lo(qw.y), bf_hi(qw.y)}, v4 = {bf_lo(vw.x), bf_hi(vw.x), bf_lo(vw.y), bf_hi(vw.y)};
          f32x4 f4 = {__builtin_amdgcn_exp2f(h_lo(gw.x)), __builtin_amdgcn_exp2f(h_hi(gw.x)), __builtin_amdgcn_exp2f(h_lo(gw.y)), __builtin_amdgcn_exp2f(h_hi(gw.y))};
          const f32x4 k4 = 1.f - f4;
          *(LAS f32x4*)(qs + tt * 128 + c4) = q4; *(LAS f32x4*)(fs + tt * 128 + c4) = f4; *(LAS f32x4*)(ks + tt * 128 + c4) = k4; *(LAS f32x4*)(vs + tt * 128 + c4) = v4; }
        __syncthreads();
        for (int s = 0; s < 16; ++s) {
            const float vt = vs[s * 128 + 16 * w + vi]; float o = 0.f;
#pragma unroll
            for (int j = 0; j < 8; ++j) {
                const f32x4 f4 = *(const LAS f32x4*)(fs + s * 128 + 32 * dq + 4 * j), k4 = *(const LAS f32x4*)(ks + s * 128 + 32 * dq + 4 * j), q4 = *(const LAS f32x4*)(qs + s * 128 + 32 * dq + 4 * j);
#pragma unroll
                for (int e = 0; e < 4; ++e) { S[4 * j + e] = f4[e] * S[4 * j + e] + k4[e] * vt; o += q4[e] * S[4 * j + e]; }
            }
            o += __shfl_xor(o, 16); o += __shfl_xor(o, 32);
            if (dq == 0) os[s * 128 + 16 * w + vi] = o;
        }
        __syncthreads();
        { const f32x4 o4 = *(const LAS f32x4*)(os + tt * 128 + c4); float ss = (o4.x * o4.x + o4.y * o4.y) + (o4.z * o4.z + o4.w * o4.w);
#pragma unroll
          for (int x = 1; x < 32; x <<= 1) ss += __shfl_xor(ss, x);
          const float rstd = 1.f / sqrtf(ss * (1.f / 128.f) + EPS);
          const f32x4 g4 = *(const f32x4*)(hnw + h * 128 + c4); const uint2 sw = *(const uint2*)(SG + off);
          uint2 ow; ow.x = pk2(o4.x * rstd * g4.x * bf_lo(sw.x), o4.y * rstd * g4.y * bf_hi(sw.x)); ow.y = pk2(o4.z * rstd * g4.z * bf_lo(sw.y), o4.w * rstd * g4.w * bf_hi(sw.y));
          *(uint2*)(QH + off) = ow; }
    }
}
__device__ __forceinline__ void attn_naive(unsigned char* ws, const float* sinks, int gw, int ngw, int lane) {
    bf16* AQ = (bf16*)(ws + WS_AQ); const bf16* AK = (const bf16*)(ws + WS_AK); const bf16* AV = (const bf16*)(ws + WS_AV); const bf16* AG = (const bf16*)(ws + WS_AG);
    for (int task = gw; task < BATCH * AT_HQ * T; task += ngw) {
        const int t = task & (T - 1), bh = task >> 13, head = bh & 15, b = bh >> 4, kvh = head >> 2;
        const size_t row = (size_t)b * T + t;
        float q[64];
        { const v4u* qp = (const v4u*)(AQ + row * 1024 + head * 64);
#pragma unroll
          for (int i = 0; i < 8; ++i) { const v4u x = qp[i]; q[8 * i] = bf_lo(x.x); q[8 * i + 1] = bf_hi(x.x); q[8 * i + 2] = bf_lo(x.y); q[8 * i + 3] = bf_hi(x.y); q[8 * i + 4] = bf_lo(x.z); q[8 * i + 5] = bf_hi(x.z); q[8 * i + 6] = bf_lo(x.w); q[8 * i + 7] = bf_hi(x.w); } }
        float s0 = -INFINITY, s1 = -INFINITY;
#pragma unroll
        for (int jj = 0; jj < 2; ++jj) { const int pos = t - 127 + lane + 64 * jj;
            if (pos >= 0) { const v4u* kp = (const v4u*)(AK + ((size_t)b * T + pos) * 256 + kvh * 64); float a = 0.f;
#pragma unroll
                for (int i = 0; i < 8; ++i) { const v4u x = kp[i];
                    a += q[8 * i] * bf_lo(x.x) + q[8 * i + 1] * bf_hi(x.x) + q[8 * i + 2] * bf_lo(x.y) + q[8 * i + 3] * bf_hi(x.y) + q[8 * i + 4] * bf_lo(x.z) + q[8 * i + 5] * bf_hi(x.z) + q[8 * i + 6] * bf_lo(x.w) + q[8 * i + 7] * bf_hi(x.w); }
                if (jj == 0) s0 = a; else s1 = a; } }
        const float sink2 = sinks[head] * LOG2E;
        float mx = fmaxf(fmaxf(s0, s1), sink2);
#pragma unroll
        for (int x = 1; x < 64; x <<= 1) mx = fmaxf(mx, __shfl_xor(mx, x));
        const float p0 = __builtin_amdgcn_exp2f(s0 - mx), p1 = __builtin_amdgcn_exp2f(s1 - mx);
        const float den = wave_sum(p0 + p1) + __builtin_amdgcn_exp2f(sink2 - mx);
        float o = 0.f;
#pragma unroll 8
        for (int j = 0; j < 128; ++j) { const int pos = t - 127 + j; const float pj = __shfl(j < 64 ? p0 : p1, j & 63);
            if (pos >= 0) o += pj * bf2f(AV[((size_t)b * T + pos) * 256 + kvh * 64 + lane]); }
        const float g = bf2f(AG[row * 1024 + head * 64 + lane]);
        AQ[row * 1024 + head * 64 + lane] = (bf16)f2bf(o / den * g);
    }
}

namespace att {
typedef short bf16x8 __attribute__((ext_vector_type(8)));
typedef short s16x4 __attribute__((ext_vector_type(4)));
typedef float f32x16 __attribute__((ext_vector_type(16)));
constexpr int LDS_K = 0, LDS_V = 32768, LDS_WSF = 65536, LDS_OST = 65536 + 2048, LDS_BYTES = LDS_OST + 8 * 8192;
__device__ __forceinline__ int crow(int r, int hi) { return (r & 3) + 8 * (r >> 2) + 4 * hi; }
__device__ __forceinline__ s16x4 vtr(const LAS unsigned char* p) { return __builtin_bit_cast(s16x4, __builtin_amdgcn_ds_read_tr16_b64_v4i16((LAS s16x4*)p)); }
__device__ __forceinline__ unsigned pkbf(float lo, float hi) { return pg8::cvt_pk_bf16(lo, hi); }

__device__ __forceinline__ void attn_unit(Frame& F, unsigned char* ws, const float* sinks, int unit) {
    const int blk = unit & 63, kvh = (unit >> 6) & 3, b = unit >> 8;
    const int lane = F.lane, r32 = lane & 31, hi = lane >> 5, wid = F.wave;
    bf16* AQ = (bf16*)(ws + WS_AQ); const bf16* AK = (const bf16*)(ws + WS_AK); const bf16* AV = (const bf16*)(ws + WS_AV); const bf16* AG = (const bf16*)(ws + WS_AG);
    const size_t rowbase = (size_t)b * T; const long key0 = 128L * blk - 128;
    LAS unsigned char* L = F.lds + RING_OFF;
    const int t_lo = (blk == 0) ? 2 : 0;
    for (int t = t_lo; t < 4; ++t) {
        const bf16* ks = AK + (size_t)(rowbase + key0 + 64 * t + lane) * 256 + kvh * 64 + wid * 8;
        __builtin_amdgcn_global_load_lds((const unsigned*)ks, (LAS unsigned*)(L + LDS_K + t * 8192 + wid * 1024), 16, 0, 0);
        const bf16* vs = AV + (size_t)(rowbase + key0 + 64 * t + 16 * (wid & 3) + (lane >> 2)) * 256 + kvh * 64 + (wid >> 2) * 32 + (lane & 3) * 8;
        __builtin_amdgcn_global_load_lds((const unsigned*)vs, (LAS unsigned*)(L + LDS_V + t * 8192 + wid * 1024), 16, 0, 0);
    }
    asm volatile("s_waitcnt vmcnt(0)" ::: "memory");
    __syncthreads();
    LAS float* wsf = (LAS float*)(L + LDS_WSF) + wid * 64;
    LAS float* stg = (LAS float*)(L + LDS_OST + wid * 8192);
    const int g = wid & 3, head = 4 * kvh + g;
    const float sink2 = sinks[head] * LOG2E;
    const int voff = ((lane >> 4) & 1) * 32 + (lane & 3) * 8 + (4 * hi + ((lane & 15) >> 2)) * 64;
#pragma unroll 1
    for (int task = 0; task < 2; ++task) {
        const int rb = (wid >> 2) + 2 * task;
        const size_t qrow0 = rowbase + 128 * (size_t)blk + 32 * rb;
        bf16x8 qr[4];
#pragma unroll
        for (int d0 = 0; d0 < 4; ++d0) qr[d0] = *(const bf16x8*)(AQ + (qrow0 + r32) * 1024 + head * 64 + d0 * 16 + hi * 8);
        f32x16 sc[5];
        float mx = -INFINITY;
#pragma unroll
        for (int hi_ = 0; hi_ < 5; ++hi_) {
            const int hh = rb + hi_, t = hh >> 1, half = hh & 1;
            const bool inval = (blk == 0) && (hh < 4);
            f32x16 acc = {0.f, 0.f, 0.f, 0.f, 0.f, 0.f, 0.f, 0.f, 0.f, 0.f, 0.f, 0.f, 0.f, 0.f, 0.f, 0.f};
            if (!inval) {
                const LAS unsigned char* kb = L + LDS_K + t * 8192 + hi * 1024 + (half * 32 + r32) * 16;
#pragma unroll
                for (int d0 = 0; d0 < 4; ++d0) { const bf16x8 kf = *(const LAS bf16x8*)(kb + d0 * 2048); acc = __builtin_amdgcn_mfma_f32_32x32x16_bf16(kf, qr[d0], acc, 0, 0, 0); }
            }
#pragma unroll
            for (int r = 0; r < 16; ++r) {
                bool ok = !inval;
                if (hi_ == 0) ok = ok && (crow(r, hi) > r32);
                if (hi_ == 4) ok = ok && (crow(r, hi) <= r32);
                const float v = ok ? acc[r] : -INFINITY;
                acc[r] = v; mx = fmaxf(mx, v);
            }
            sc[hi_] = acc;
        }
        mx = fmaxf(mx, __shfl_xor(mx, 32)); mx = fmaxf(mx, sink2);
        float l = 0.f;
#pragma unroll
        for (int hi_ = 0; hi_ < 5; ++hi_)
#pragma unroll
            for (int r = 0; r < 16; ++r) { const float p = __builtin_amdgcn_exp2f(sc[hi_][r] - mx); sc[hi_][r] = p; l += p; }
        l += __shfl_xor(l, 32); l += __builtin_amdgcn_exp2f(sink2 - mx);
        if (hi == 0) wsf[r32] = l;
        f32x16 o[2];
        o[0] = (f32x16){0.f, 0.f, 0.f, 0.f, 0.f, 0.f, 0.f, 0.f, 0.f, 0.f, 0.f, 0.f, 0.f, 0.f, 0.f, 0.f}; o[1] = o[0];
#pragma unroll
        for (int hi_ = 0; hi_ < 5; ++hi_) {
            const int hh = rb + hi_, t = hh >> 1, half = hh & 1;
            const bool inval = (blk == 0) && (hh < 4);
            if (!inval) {
#pragma unroll
                for (int ks = 0; ks < 2; ++ks) {
                    typedef unsigned u32x4_t __attribute__((ext_vector_type(4)));
                    u32x4_t pw; pw.x = pkbf(sc[hi_][8 * ks + 0], sc[hi_][8 * ks + 1]); pw.y = pkbf(sc[hi_][8 * ks + 2], sc[hi_][8 * ks + 3]); pw.z = pkbf(sc[hi_][8 * ks + 4], sc[hi_][8 * ks + 5]); pw.w = pkbf(sc[hi_][8 * ks + 6], sc[hi_][8 * ks + 7]);
                    const bf16x8 pa = __builtin_bit_cast(bf16x8, pw);
#pragma unroll
                    for (int d0 = 0; d0 < 2; ++d0) {
                        const LAS unsigned char* vp = L + LDS_V + t * 8192 + d0 * 4096 + (2 * half + ks) * 1024 + voff;
                        const s16x4 lo = vtr(vp), h4 = vtr(vp + 512);
                        const bf16x8 vf = {lo[0], lo[1], lo[2], lo[3], h4[0], h4[1], h4[2], h4[3]};
                        o[d0] = __builtin_amdgcn_mfma_f32_32x32x16_bf16(pa, vf, o[d0], 0, 0, 0);
                    }
                }
            }
        }
        asm volatile("s_waitcnt lgkmcnt(0)" ::: "memory");
#pragma unroll
        for (int r = 0; r < 16; ++r) { const float rl = __builtin_amdgcn_rcpf(wsf[crow(r, hi)]);
#pragma unroll
            for (int d0 = 0; d0 < 2; ++d0) stg[crow(r, hi) * 64 + d0 * 32 + r32] = o[d0][r] * rl; }
        asm volatile("s_waitcnt lgkmcnt(0)" ::: "memory");
#pragma unroll
        for (int i = 0; i < 4; ++i) {
            const int row = i * 8 + (lane >> 3), c8 = (lane & 7) * 8;
            const f32x4 a = *(const LAS f32x4*)(stg + row * 64 + c8), c = *(const LAS f32x4*)(stg + row * 64 + c8 + 4);
            const size_t off = (qrow0 + row) * 1024 + head * 64 + c8;
            const v4u gg = *(const v4u*)(AG + off);
            v4u ov; ov.x = pkbf(a[0] * bf_lo(gg.x), a[1] * bf_hi(gg.x)); ov.y = pkbf(a[2] * bf_lo(gg.y), a[3] * bf_hi(gg.y)); ov.z = pkbf(c[0] * bf_lo(gg.z), c[1] * bf_hi(gg.z)); ov.w = pkbf(c[2] * bf_lo(gg.w), c[3] * bf_hi(gg.w));
            *(v4u*)(AQ + off) = ov;
        }
        asm volatile("s_waitcnt lgkmcnt(0)" ::: "memory");
    }
    __syncthreads();
}
}

namespace hg {
typedef short bf16x8 __attribute__((ext_vector_type(8)));
typedef _Float16 f16x8 __attribute__((ext_vector_type(8)));
typedef short s16x4 __attribute__((ext_vector_type(4)));
typedef float f32x16 __attribute__((ext_vector_type(16)));
typedef unsigned u32x2 __attribute__((ext_vector_type(2)));
constexpr int QRAW = 0, GRAW = 16384, VIMG = 32768, QT = 49152, KT = 65536, KH = 81920, SBT = 98304, PM = 131072, BEND = 139264, PART = 139776, OST = QT;
constexpr size_t WS_U = WS_MISC + 1 * MiB, WS_BTOT = WS_MISC + 20 * MiB;
__device__ __forceinline__ int crow(int r, int hi) { return (r & 3) + 8 * (r >> 2) + 4 * hi; }
__device__ __forceinline__ s16x4 vtr(const LAS unsigned char* p) { return __builtin_bit_cast(s16x4, __builtin_amdgcn_ds_read_tr16_b64_v4i16((LAS s16x4*)p)); }
__device__ __forceinline__ bf16x8 tr_frag(const LAS unsigned char* p) { const s16x4 lo = vtr(p), h4 = vtr(p + 512); return (bf16x8){lo[0], lo[1], lo[2], lo[3], h4[0], h4[1], h4[2], h4[3]}; }
__device__ __forceinline__ unsigned pkbf(float lo, float hi) { return pg8::cvt_pk_bf16(lo, hi); }
__device__ __forceinline__ int tr_off(int row, int col) { return (col >> 5) * 4096 + (row >> 4) * 1024 + (row & 15) * 64 + (col & 31) * 2; }
__device__ __forceinline__ int row_off(int row, int chunk) { return row * 256 + ((chunk ^ (row & 15)) << 4); }

template <int MODE> __device__ __forceinline__ void hgrn_unit(Frame& F, unsigned char* ws, const float* hnw, int unit) {
    const int sc = unit & 15, bh = unit >> 4, h = bh & 7, b = bh >> 3;
    const int tid = F.tid, lane = F.lane, r32 = lane & 31, hi = lane >> 5, w = F.wave;
    LAS unsigned char* L = F.lds + RING_OFF;
    bf16* QH = (bf16*)(ws + WS_QH); const bf16* GH = (const bf16*)(ws + WS_GH); const bf16* VH = (const bf16*)(ws + WS_VH); const bf16* SG = (const bf16*)(ws + WS_SG);
    float* Ubuf = (float*)(ws + WS_U); float* Btot = (float*)(ws + WS_BTOT);
    const size_t row0 = (size_t)b * T + (size_t)sc * 512;
    const int voff = ((lane >> 4) & 1) * 32 + (lane & 3) * 8 + (4 * hi + ((lane & 15) >> 2)) * 64;
    const int vb = w >> 1, tb = w & 1, dbc = w >> 1;
    f16x8 Lf[2], Lone;
#pragma unroll
    for (int ksr = 0; ksr < 2; ++ksr)
#pragma unroll
        for (int e = 0; e < 8; ++e) Lf[ksr][e] = ((16 * ksr + crow(e, hi)) <= r32) ? (_Float16)1.0f : (_Float16)0.0f;
#pragma unroll
    for (int e = 0; e < 8; ++e) Lone[e] = (_Float16)1.0f;
    f32x16 S[2];
#pragma unroll
    for (int i = 0; i < 2; ++i)
#pragma unroll
        for (int r = 0; r < 16; ++r) S[i][r] = 0.f;
    float btot[16];
#pragma unroll
    for (int r = 0; r < 16; ++r) btot[r] = 0.f;
    if (MODE == 1) {
        for (int j = 0; j < sc; ++j) {
            const int uj = bh * 16 + j;
#pragma unroll
            for (int i = 0; i < 2; ++i) { const int db = 2 * (w & 1) + i;
#pragma unroll
                for (int a = 0; a < 4; ++a) { const f32x4 bt = *(const f32x4*)(Btot + (size_t)uj * 128 + 32 * db + 8 * a + 4 * hi);
#pragma unroll
                    for (int e = 0; e < 4; ++e) { const int r = 4 * a + e; S[i][r] = __builtin_amdgcn_exp2f(bt[e]) * S[i][r] + Ubuf[(((size_t)uj * 8 + w) * 2 + i) * 1024 + r * 64 + lane]; } } }
        }
#pragma unroll
        for (int i = 0; i < 2; ++i) { const int db = 2 * (w & 1) + i, v = 32 * vb + r32;
#pragma unroll
            for (int a = 0; a < 4; ++a) { u32x2 pw; pw.x = pkbf(S[i][4 * a], S[i][4 * a + 1]); pw.y = pkbf(S[i][4 * a + 2], S[i][4 * a + 3]);
                *(LAS u32x2*)(L + SBT + row_off(v, 4 * db + a) + 8 * hi) = pw; } }
    }
#pragma unroll 1
    for (int c = 0; c < 8; ++c) {
        const size_t t0 = row0 + 64 * c;
#pragma unroll
        for (int pp = 0; pp < 2; ++pp) { const int p = w * 2 + pp, cb = p >> 2, ks = p & 3;
            const size_t goff = (t0 + 16 * ks + (lane >> 2)) * 1024 + h * 128 + 32 * cb + (lane & 3) * 8;
            __builtin_amdgcn_global_load_lds((const unsigned*)(GH + goff), (LAS unsigned*)(L + GRAW + cb * 4096 + ks * 1024), 16, 0, 0);
            __builtin_amdgcn_global_load_lds((const unsigned*)(VH + goff), (LAS unsigned*)(L + VIMG + cb * 4096 + ks * 1024), 16, 0, 0);
            if (MODE == 1) __builtin_amdgcn_global_load_lds((const unsigned*)(QH + goff), (LAS unsigned*)(L + QRAW + cb * 4096 + ks * 1024), 16, 0, 0);
        }
        asm volatile("s_waitcnt vmcnt(0)" ::: "memory");
        __syncthreads();
        f32x16 bT;
#pragma unroll
        for (int r = 0; r < 16; ++r) bT[r] = 0.f;
        {
            const LAS unsigned char* gp = L + GRAW + dbc * 4096 + voff;
            if (tb == 0) {
#pragma unroll
                for (int ks = 0; ks < 2; ++ks) { const f16x8 gf = __builtin_bit_cast(f16x8, tr_frag(gp + ks * 1024)); bT = __builtin_amdgcn_mfma_f32_32x32x16_f16(gf, Lf[ks], bT, 0, 0, 0); }
            } else {
#pragma unroll
                for (int ks = 0; ks < 4; ++ks) { const f16x8 gf = __builtin_bit_cast(f16x8, tr_frag(gp + ks * 1024)); bT = __builtin_amdgcn_mfma_f32_32x32x16_f16(gf, ks < 2 ? Lone : Lf[ks - 2], bT, 0, 0, 0); }
            }
        }
        const int t = 32 * tb + r32;
        float kt[16];
#pragma unroll
        for (int a = 0; a < 4; ++a) {
            const int dl = 8 * a + 4 * hi;
            const int toff = dbc * 4096 + (t >> 4) * 1024 + (t & 15) * 64 + dl * 2;
            const u32x2 gw = *(const LAS u32x2*)(L + GRAW + toff);
            const float g0 = h_lo(gw.x), g1 = h_hi(gw.x), g2 = h_lo(gw.y), g3 = h_hi(gw.y);
            const float k0 = 1.f - __builtin_amdgcn_exp2f(g0), k1 = 1.f - __builtin_amdgcn_exp2f(g1), k2 = 1.f - __builtin_amdgcn_exp2f(g2), k3 = 1.f - __builtin_amdgcn_exp2f(g3);
            kt[4 * a] = k0 * __builtin_amdgcn_exp2f(-bT[4 * a]); kt[4 * a + 1] = k1 * __builtin_amdgcn_exp2f(-bT[4 * a + 1]);
            kt[4 * a + 2] = k2 * __builtin_amdgcn_exp2f(-bT[4 * a + 2]); kt[4 * a + 3] = k3 * __builtin_amdgcn_exp2f(-bT[4 * a + 3]);
            if (MODE == 1) {
                const u32x2 qw = *(const LAS u32x2*)(L + QRAW + toff);
                u32x2 qo, ko;
                qo.x = pkbf(bf_lo(qw.x) * __builtin_amdgcn_exp2f(bT[4 * a]), bf_hi(qw.x) * __builtin_amdgcn_exp2f(bT[4 * a + 1]));
                qo.y = pkbf(bf_lo(qw.y) * __builtin_amdgcn_exp2f(bT[4 * a + 2]), bf_hi(qw.y) * __builtin_amdgcn_exp2f(bT[4 * a + 3]));
                ko.x = pkbf(kt[4 * a], kt[4 * a + 1]); ko.y = pkbf(kt[4 * a + 2], kt[4 * a + 3]);
                const int ro = row_off(t, 4 * dbc + a) + 8 * hi;
                *(LAS u32x2*)(L + QT + ro) = qo; *(LAS u32x2*)(L + KT + ro) = ko;
            }
            if (tb == 1 && r32 == 31) { *(LAS f32x4*)(L + BEND + (32 * dbc + dl) * 4) = (f32x4){bT[4 * a], bT[4 * a + 1], bT[4 * a + 2], bT[4 * a + 3]};
                if (MODE == 0) { btot[4 * a] += bT[4 * a]; btot[4 * a + 1] += bT[4 * a + 1]; btot[4 * a + 2] += bT[4 * a + 2]; btot[4 * a + 3] += bT[4 * a + 3]; } }
        }
        __syncthreads();
#pragma unroll
        for (int a = 0; a < 4; ++a) {
            const int dl = 8 * a + 4 * hi;
            const f32x4 be = *(const LAS f32x4*)(L + BEND + (32 * dbc + dl) * 4);
            u32x2 ho; ho.x = pkbf(kt[4 * a] * __builtin_amdgcn_exp2f(be[0]), kt[4 * a + 1] * __builtin_amdgcn_exp2f(be[1])); ho.y = pkbf(kt[4 * a + 2] * __builtin_amdgcn_exp2f(be[2]), kt[4 * a + 3] * __builtin_amdgcn_exp2f(be[3]));
            *(LAS u32x2*)(L + KH + dbc * 4096 + (t >> 4) * 1024 + (t & 15) * 64 + dl * 2) = ho;
        }
        f32x16 o;
        if (MODE == 1) {
            const int l15 = lane & 15, g4 = lane >> 4;
#pragma unroll
            for (int rep = 0; rep < 2; ++rep) {
                const int ti = w + 8 * rep;
                if (ti < 12) {
                    int sb4, tb4;
                    if (ti < 4) { sb4 = ti; tb4 = ti; } else if (ti == 4) { sb4 = 0; tb4 = 1; } else if (ti == 5) { sb4 = 0; tb4 = 2; } else if (ti == 6) { sb4 = 0; tb4 = 3; }
                    else if (ti == 7) { sb4 = 1; tb4 = 2; } else if (ti == 8) { sb4 = 1; tb4 = 3; } else if (ti == 9) { sb4 = 2; tb4 = 3; } else if (ti == 10) { sb4 = 1; tb4 = 0; } else { sb4 = 3; tb4 = 2; }
                    f32x4 pa = {0.f, 0.f, 0.f, 0.f};
                    if (ti < 10) {
                        const int rs = 16 * sb4 + l15, rt = 16 * tb4 + l15;
#pragma unroll
                        for (int kk = 0; kk < 4; ++kk) { const bf16x8 af = *(const LAS bf16x8*)(L + KT + row_off(rs, 4 * kk + g4)), bfr = *(const LAS bf16x8*)(L + QT + row_off(rt, 4 * kk + g4));
                            pa = __builtin_amdgcn_mfma_f32_16x16x32_bf16(af, bfr, pa, 0, 0, 0); }
                    }
                    const int tt = 16 * tb4 + l15, s0 = 16 * sb4 + 4 * g4;
                    u32x2 pw; pw.x = pkbf((s0 <= tt) ? pa[0] : 0.f, (s0 + 1 <= tt) ? pa[1] : 0.f); pw.y = pkbf((s0 + 2 <= tt) ? pa[2] : 0.f, (s0 + 3 <= tt) ? pa[3] : 0.f);
                    *(LAS u32x2*)(L + PM + tt * 128 + (((2 * sb4 + (g4 & 1)) ^ ((tt >> 1) & 7)) << 4) + 8 * (g4 >> 1)) = pw;
                }
            }
#pragma unroll
            for (int r = 0; r < 16; ++r) o[r] = 0.f;
            { const int rv = 32 * vb + r32, rt = 32 * tb + r32;
#pragma unroll
              for (int kd = 0; kd < 8; ++kd) { const bf16x8 af = *(const LAS bf16x8*)(L + SBT + row_off(rv, 2 * kd + hi)), bfr = *(const LAS bf16x8*)(L + QT + row_off(rt, 2 * kd + hi));
                  o = __builtin_amdgcn_mfma_f32_32x32x16_bf16(af, bfr, o, 0, 0, 0); } }
        }
        __syncthreads();
        if (MODE == 1) {
            const int rt = 32 * tb + r32;
#pragma unroll
            for (int ks = 0; ks < 4; ++ks) if (ks < 2 || tb == 1) {
                const bf16x8 af = tr_frag(L + VIMG + vb * 4096 + ks * 1024 + voff);
                const bf16x8 bfr = *(const LAS bf16x8*)(L + PM + rt * 128 + (((2 * ks + hi) ^ ((rt >> 1) & 7)) << 4));
                o = __builtin_amdgcn_mfma_f32_32x32x16_bf16(af, bfr, o, 0, 0, 0);
            }
        }
        if (MODE == 0 || c < 7) {
#pragma unroll
            for (int i = 0; i < 2; ++i) { const int db = 2 * (w & 1) + i;
#pragma unroll
                for (int a = 0; a < 4; ++a) { const f32x4 be = *(const LAS f32x4*)(L + BEND + (32 * db + 8 * a + 4 * hi) * 4);
#pragma unroll
                    for (int e = 0; e < 4; ++e) S[i][4 * a + e] *= __builtin_amdgcn_exp2f(be[e]); }
#pragma unroll
                for (int ks = 0; ks < 4; ++ks) { const bf16x8 af = tr_frag(L + KH + db * 4096 + ks * 1024 + voff), bfr = tr_frag(L + VIMG + vb * 4096 + ks * 1024 + voff);
                    S[i] = __builtin_amdgcn_mfma_f32_32x32x16_bf16(af, bfr, S[i], 0, 0, 0); }
                if (MODE == 1) { const int v = 32 * vb + r32;
#pragma unroll
                    for (int a = 0; a < 4; ++a) { u32x2 pw; pw.x = pkbf(S[i][4 * a], S[i][4 * a + 1]); pw.y = pkbf(S[i][4 * a + 2], S[i][4 * a + 3]);
                        *(LAS u32x2*)(L + SBT + row_off(v, 4 * db + a) + 8 * hi) = pw; } }
            }
        }
        if (MODE == 1) {
            float ss = 0.f;
#pragma unroll
            for (int r = 0; r < 16; ++r) ss += o[r] * o[r];
            ss += __shfl_xor(ss, 32);
            const int rt = 32 * tb + r32;
            if (hi == 0) *(LAS float*)(L + PART + (vb * 64 + rt) * 4) = ss;
#pragma unroll
            for (int a = 0; a < 4; ++a) { const int c16 = (32 * vb + 8 * a + 4 * hi) >> 2;
                *(LAS f32x4*)(L + OST + rt * 512 + ((c16 ^ (rt & 7)) << 4)) = (f32x4){o[4 * a], o[4 * a + 1], o[4 * a + 2], o[4 * a + 3]}; }
            __syncthreads();
            { const int tt = tid >> 3, seg = tid & 7;
              const float sq = *(const LAS float*)(L + PART + tt * 4) + *(const LAS float*)(L + PART + (64 + tt) * 4) + *(const LAS float*)(L + PART + (128 + tt) * 4) + *(const LAS float*)(L + PART + (192 + tt) * 4);
              const float rstd = 1.f / sqrtf(sq * (1.f / 128.f) + EPS);
              const size_t goff = (t0 + tt) * 1024 + h * 128 + seg * 16;
              const v4u g0 = *(const v4u*)(SG + goff), g1 = *(const v4u*)(SG + goff + 8);
              f32x4 ov[4], wv[4];
#pragma unroll
              for (int j = 0; j < 4; ++j) { ov[j] = *(const LAS f32x4*)(L + OST + tt * 512 + (((seg * 4 + j) ^ (tt & 7)) << 4)); wv[j] = *(const f32x4*)(hnw + h * 128 + seg * 16 + 4 * j); ov[j] = ov[j] * rstd * wv[j]; }
              v4u o0, o1;
              o0.x = pkbf(ov[0][0] * bf_lo(g0.x), ov[0][1] * bf_hi(g0.x)); o0.y = pkbf(ov[0][2] * bf_lo(g0.y), ov[0][3] * bf_hi(g0.y)); o0.z = pkbf(ov[1][0] * bf_lo(g0.z), ov[1][1] * bf_hi(g0.z)); o0.w = pkbf(ov[1][2] * bf_lo(g0.w), ov[1][3] * bf_hi(g0.w));
              o1.x = pkbf(ov[2][0] * bf_lo(g1.x), ov[2][1] * bf_hi(g1.x)); o1.y = pkbf(ov[2][2] * bf_lo(g1.y), ov[2][3] * bf_hi(g1.y)); o1.z = pkbf(ov[3][0] * bf_lo(g1.z), ov[3][1] * bf_hi(g1.z)); o1.w = pkbf(ov[3][2] * bf_lo(g1.w), ov[3][3] * bf_hi(g1.w));
              *(v4u*)(QH + goff) = o0; *(v4u*)(QH + goff + 8) = o1; }
        }
        __syncthreads();
    }
    if (MODE == 0) {
#pragma unroll
        for (int i = 0; i < 2; ++i)
#pragma unroll
            for (int r = 0; r < 16; ++r) Ubuf[(((size_t)unit * 8 + w) * 2 + i) * 1024 + r * 64 + lane] = S[i][r];
        if (tb == 1 && r32 == 31) {
#pragma unroll
            for (int a = 0; a < 4; ++a) *(f32x4*)(Btot + (size_t)unit * 128 + 32 * dbc + 8 * a + 4 * hi) = (f32x4){btot[4 * a], btot[4 * a + 1], btot[4 * a + 2], btot[4 * a + 3]};
        }
    }
}
}

struct Args { const float* in[10]; float* out; unsigned char* ws; int ph_lo, ph_hi; };
constexpr int N_PHASES = 9;
__global__ void __launch_bounds__(NWAVES * 64, 2) fwd_kernel(Args args) {
    extern __shared__ __attribute__((aligned(16))) unsigned char lds[];
    Frame F;
    F.lds = (LAS unsigned char*)lds;
    F.MISC = (volatile LAS unsigned*)(F.lds + MISC_OFF);
    F.tid = threadIdx.x; F.lane = F.tid & 63; F.wave = __builtin_amdgcn_readfirstlane(F.tid >> 6);
    F.G = gridDim.x; { const int bx = blockIdx.x; F.vcu = (F.G % 8 == 0) ? (bx % 8) * (F.G / 8) + bx / 8 : bx; }
    unsigned char* ws = args.ws;
    F.ctl = (gu32*)(ws + WS_CTL);
    const float* x = args.in[0]; const float* norm_w = args.in[1]; const float* w_in = args.in[2]; const float* hlb = args.in[3]; const float* hnw = args.in[4];
    const float* w_bh = args.in[5]; const float* sinks = args.in[6]; const float* w_ba = args.in[7]; const float* w_out = args.in[8]; const float* fnw = args.in[9];
    float* out = args.out;
    bf16* XN = (bf16*)out;
    bf16* WinT = (bf16*)(ws + WS_WIN); bf16* WbhT = (bf16*)(ws + WS_WBH); bf16* WbaT = (bf16*)(ws + WS_WBA); bf16* WoutT = (bf16*)(ws + WS_WOUT);
    float* lbv = (float*)(ws + WS_MISC);
    for (int u = F.tid; u < (LDS_BYTES - LDSCTL_OFF) / 4; u += NWAVES * 64) ((LAS unsigned*)(F.lds + LDSCTL_OFF))[u] = 0u;
    __syncthreads();
    XcdBarrier bar = xcd_barrier_post((unsigned*)(F.ctl + CW_BAR), F.MISC + 8);
    const int lo = args.ph_lo, hi = args.ph_hi;
#define IN(k) (lo <= (k) && (k) < hi)
#define BOTH(k) (IN(k) && IN((k) + 1))
    const int gw = F.vcu * NWAVES + F.wave, NGW = F.G * NWAVES;

    if (IN(0)) {
        LAS float* scr = (LAS float*)(F.lds + RING_OFF + F.wave * 16384);
        constexpr int I_IN = (D / 64) * (DIN / 32), I_SQ = (D / 64) * (D / 32), NITEMS = I_IN + 3 * I_SQ;
        for (int it = gw; it < NITEMS; it += NGW) {
            int r = it;
            if (r < I_IN) { p0_transpose_item(w_in, D, DIN, WinT, 0, scr, r, F.lane); continue; } r -= I_IN;
            if (r < I_SQ) { p0_transpose_item(w_bh, D, D, WbhT, 0, scr, r, F.lane); continue; } r -= I_SQ;
            if (r < I_SQ) { p0_transpose_item(w_ba, D, D, WbaT, 0, scr, r, F.lane); continue; } r -= I_SQ;
            p0_transpose_item(w_out, D, D, WoutT, 0, scr, r, F.lane);
        }
        for (int m = gw; m < M; m += NGW) rms_row_to_bf16(F.lane, x + (size_t)m * D, norm_w, XN + (size_t)m * D);
        if (blockIdx.x == 0) for (int i = F.tid; i < 1024; i += NWAVES * 64) lbv[i] = 1.f / (1.f + __expf(hlb[1024 + i] - hlb[i]));
        if (BOTH(0)) xcd_barrier(bar);
    }
    if (IN(1)) {
        pg8::Gemm g{XN, WinT, M, NT_A * 256, D}; pg8::StaticOrder S; S.init(M, NT_A * 256, F.G, (int)blockIdx.x);
        pg8::EpiProj E{ws, lbv, 0};
        pg8::gemm_phase<pg8::EpiProj, pg8::StaticOrder, true, true>(F.lds + RING_OFF, g, S, E);
        if (BOTH(1)) xcd_barrier(bar);
    }
    if (IN(2)) {
        hg::hgrn_unit<0>(F, ws, hnw, F.vcu);
        for (int u = F.vcu; u < 512; u += F.G) att::attn_unit(F, ws, sinks, u);
        if (BOTH(2)) xcd_barrier(bar);
    }
    if (IN(3)) {
        hg::hgrn_unit<1>(F, ws, hnw, F.vcu);
        if (BOTH(3)) xcd_barrier(bar);
    }
    if (IN(4)) {
        pg8::Gemm g{XN, WinT + (size_t)NT_A * 256 * D, M, NT_B * 256, D}; pg8::StaticOrder S; S.init(M, NT_B * 256, F.G, (int)blockIdx.x);
        pg8::EpiProj E{ws, lbv, NT_A};
        pg8::gemm_phase<pg8::EpiProj, pg8::StaticOrder, true, true>(F.lds + RING_OFF, g, S, E);
        if (BOTH(4)) xcd_barrier(bar);
    }
    if (IN(5)) {
        { pg8::Gemm g{(const bf16*)(ws + WS_QH), WbhT, M, D, D}; pg8::StaticOrder S; S.init(M, D, F.G, (int)blockIdx.x);
          pg8::EpiBf16<0> E{(bf16*)(ws + WS_YH), D, nullptr, 0, 0, 1.f};
          pg8::gemm_phase<pg8::EpiBf16<0>, pg8::StaticOrder, true, true>(F.lds + RING_OFF, g, S, E); }
        { pg8::Gemm g{(const bf16*)(ws + WS_AQ), WbaT, M, D, D}; pg8::StaticOrder S; S.init(M, D, F.G, (int)blockIdx.x);
          pg8::EpiBf16<0> E{(bf16*)(ws + WS_YA), D, nullptr, 0, 0, 1.f};
          pg8::gemm_phase<pg8::EpiBf16<0>, pg8::StaticOrder, true, true>(F.lds + RING_OFF, g, S, E); }
        if (BOTH(5)) xcd_barrier(bar);
    }
    if (IN(6)) {
        const v4u* MH = (const v4u*)(ws + WS_MH); const v4u* MA = (const v4u*)(ws + WS_MA); const v4u* YH = (const v4u*)(ws + WS_YH); const v4u* YA = (const v4u*)(ws + WS_YA); v4u* MG = (v4u*)(ws + WS_MERGED);
        for (size_t i = (size_t)F.vcu * (NWAVES * 64) + F.tid; i < (size_t)M * D / 8; i += (size_t)F.G * NWAVES * 64) {
            const v4u a = MH[i], b = MA[i], c = YH[i], d = YA[i]; v4u o;
            o.x = pk2(bf_lo(a.x) * bf_lo(c.x) + bf_lo(b.x) * bf_lo(d.x), bf_hi(a.x) * bf_hi(c.x) + bf_hi(b.x) * bf_hi(d.x));
            o.y = pk2(bf_lo(a.y) * bf_lo(c.y) + bf_lo(b.y) * bf_lo(d.y), bf_hi(a.y) * bf_hi(c.y) + bf_hi(b.y) * bf_hi(d.y));
            o.z = pk2(bf_lo(a.z) * bf_lo(c.z) + bf_lo(b.z) * bf_lo(d.z), bf_hi(a.z) * bf_hi(c.z) + bf_hi(b.z) * bf_hi(d.z));
            o.w = pk2(bf_lo(a.w) * bf_lo(c.w) + bf_lo(b.w) * bf_lo(d.w), bf_hi(a.w) * bf_hi(c.w) + bf_hi(b.w) * bf_hi(d.w));
            MG[i] = o; }
        if (BOTH(6)) xcd_barrier(bar);
    }
    if (IN(7)) {
        pg8::Gemm g{(const bf16*)(ws + WS_MERGED), WoutT, M, D, D}; pg8::StaticOrder S; S.init(M, D, F.G, (int)blockIdx.x);
        pg8::EpiResF32 E{x, out, D};
        pg8::gemm_phase<pg8::EpiResF32, pg8::StaticOrder, true, true>(F.lds + RING_OFF, g, S, E);
        if (BOTH(7)) xcd_barrier(bar);
    }
    if (IN(8)) {
        for (int m = gw; m < M; m += NGW) rms_row_f32(F.lane, out + (size_t)m * D, fnw, out + (size_t)m * D);
    }
#undef IN
#undef BOTH
}

extern "C" void kernel_launch(void* const* d_in, const int* in_sizes, int n_in, void* d_out, int out_size, void* d_ws, size_t ws_size, hipStream_t stream) {
    static int grid = 0;
    if (grid == 0) {
        if (n_in != 10 || in_sizes[0] != M * D || out_size != M * D || ws_size < WS_END) { fprintf(stderr, "kernel_launch: unexpected shapes (n_in %d in0 %d out %d ws %zu)\n", n_in, n_in > 0 ? in_sizes[0] : -1, out_size, ws_size); grid = -1; return; }
        int dev = 0, cus = 0, per_cu = 0;
        if (hipGetDevice(&dev) != hipSuccess || hipDeviceGetAttribute(&cus, hipDeviceAttributeMultiprocessorCount, dev) != hipSuccess) { grid = -1; return; }
        if (hipFuncSetAttribute((const void*)fwd_kernel, hipFuncAttributeMaxDynamicSharedMemorySize, LDS_BYTES) != hipSuccess) { fprintf(stderr, "kernel_launch: hipFuncSetAttribute failed\n"); grid = -1; return; }
        if (hipOccupancyMaxActiveBlocksPerMultiprocessor(&per_cu, (const void*)fwd_kernel, NWAVES * 64, LDS_BYTES) != hipSuccess || per_cu < 1) { fprintf(stderr, "kernel_launch: occupancy query says %d blocks/CU\n", per_cu); }
        (void)hipGetLastError();
        grid = cus;
    }
    if (grid < 0) return;
    if (hipMemsetAsync((char*)d_ws + WS_CTL, 0, CTL_ZERO_BYTES, stream) != hipSuccess) return;
    Args a{};
    for (int i = 0; i < 10; ++i) a.in[i] = (const float*)d_in[i];
    a.out = (float*)d_out; a.ws = (unsigned char*)d_ws;
#ifndef N_LAUNCH_CUTS
    a.ph_lo = 0; a.ph_hi = N_PHASES;
    hipLaunchKernelGGL(fwd_kernel, dim3(grid), dim3(NWAVES * 64), LDS_BYTES, stream, a);
#else
    for (int p = 0; p < N_PHASES; ++p) { a.ph_lo = p; a.ph_hi = p + 1; hipLaunchKernelGGL(fwd_kernel, dim3(grid), dim3(NWAVES * 64), LDS_BYTES, stream, a); }
#endif
}
```
